# Optimizing an MI355X kernel written in HIP

```python
import jax, jax.numpy as jnp
from jax import lax
import numpy as np

D_MODEL = 1024
BATCH = 16
SEQ = 2048
DEPTH = 1

CHUNK = 64
Q_BLOCK = 2 * CHUNK
MIX_WIDTH = D_MODEL
POOL_WIDTH = MIX_WIDTH // 2
POOL_WINDOWS = (2, 4, 8, 16)
POOL_GROUP = POOL_WIDTH // len(POOL_WINDOWS)
ATTN_WIDTH = MIX_WIDTH - POOL_WIDTH
ATTN_HEADS = 8
HEAD_DIM = ATTN_WIDTH // ATTN_HEADS
IN_WIDTH = POOL_WIDTH + 3 * ATTN_WIDTH + ATTN_HEADS
PEER_HEADS = 8
PEER_KEYS = 128
PEER_EXPERTS = PEER_KEYS * PEER_KEYS
PEER_QUERY = 256
PEER_TOPK = 16
PEER_TOKEN_BLOCK = 128
EPS = 1e-6

kernel_name = "hybrid_pool_fox_peer_block"


def rms_norm(x, g):
    xf = x.astype(jnp.float32)
    y = xf * lax.rsqrt(jnp.mean(xf * xf, axis=-1, keepdims=True) + EPS)
    return (y * g.astype(jnp.float32)).astype(x.dtype)


def pool_mixer(p, w_pool, pool_scale):
    B, S, _ = p.shape
    pf = p.astype(jnp.float32)
    cs = jnp.cumsum(pf, axis=1)
    cs = jnp.concatenate([jnp.zeros_like(cs[:, :1]), cs], axis=1)
    t = jnp.arange(S)
    outs = []
    for gi, w in enumerate(POOL_WINDOWS):
        sl = slice(gi * POOL_GROUP, (gi + 1) * POOL_GROUP)
        start = jnp.maximum(t + 1 - w, 0)
        win_sum = cs[:, 1:, sl] - cs[:, start, sl]
        cnt = (t + 1 - start).astype(jnp.float32)[None, :, None]
        outs.append(win_sum / cnt - pf[:, :, sl])
    pooled = jnp.stack(outs, axis=2).astype(p.dtype)
    y = jnp.einsum('bsgc,gcd->bsgd', pooled, w_pool).reshape(B, S, POOL_WIDTH)
    return y * pool_scale


def forgetting_attention(q, k, v, log_f):
    B, S, H, Dh = q.shape
    F = jnp.cumsum(log_f, axis=1).transpose(0, 2, 1)
    scale = Dh ** -0.5
    outs = []
    for i in range(S // Q_BLOCK):
        q0 = i * Q_BLOCK
        kv_len = q0 + Q_BLOCK
        s = jnp.einsum('bqhd,bkhd->bhqk', q[:, q0:kv_len], k[:, :kv_len]).astype(jnp.float32) * scale
        s = s + F[:, :, q0:kv_len, None] - F[:, :, None, :kv_len]
        qpos = q0 + jnp.arange(Q_BLOCK)
        kpos = jnp.arange(kv_len)
        s = jnp.where(kpos[None, :] <= qpos[:, None], s, -jnp.inf)
        pr = jax.nn.softmax(s, axis=-1)
        outs.append(jnp.einsum('bhqk,bkhd->bqhd', pr.astype(v.dtype), v[:, :kv_len]))
    return jnp.concatenate(outs, axis=1)


def peer_ffn(h, w_query, sub_keys, expert_u, expert_v):
    B, S, D = h.shape
    T = B * S
    ht = h.reshape(T, D)
    q = (ht @ w_query).reshape(T, PEER_HEADS, 2, PEER_QUERY // 2)
    s1 = jnp.einsum('thc,kc->thk', q[:, :, 0], sub_keys[0]).astype(jnp.float32)
    s2 = jnp.einsum('thc,kc->thk', q[:, :, 1], sub_keys[1]).astype(jnp.float32)
    v1, i1 = lax.top_k(s1, PEER_TOPK)
    v2, i2 = lax.top_k(s2, PEER_TOPK)
    cand_s = (v1[..., :, None] + v2[..., None, :]).reshape(T, PEER_HEADS, PEER_TOPK * PEER_TOPK)
    cand_i = (i1[..., :, None] * PEER_KEYS + i2[..., None, :]).reshape(T, PEER_HEADS, PEER_TOPK * PEER_TOPK)
    top_s, top_pos = lax.top_k(cand_s, PEER_TOPK)
    expert_idx = jnp.take_along_axis(cand_i, top_pos, axis=-1)
    gates = jax.nn.softmax(top_s, axis=-1).astype(h.dtype)

    nb = T // PEER_TOKEN_BLOCK

    def block(args):
        xb, idx, g = args
        u = expert_u[idx]
        a = jax.nn.gelu(jnp.einsum('thkd,td->thk', u, xb), approximate=False)
        return jnp.einsum('thk,thkd->td', g * a, expert_v[idx])

    y = lax.map(block, (ht.reshape(nb, PEER_TOKEN_BLOCK, D),
                        expert_idx.reshape(nb, PEER_TOKEN_BLOCK, PEER_HEADS, PEER_TOPK),
                        gates.reshape(nb, PEER_TOKEN_BLOCK, PEER_HEADS, PEER_TOPK)))
    return y.reshape(B, S, D)


def setup_inputs(seed: int = 0) -> dict:
    key = jax.random.key(seed)
    ks = jax.random.split(key, 16)
    f32 = jnp.float32
    nrm = lambda k, shape, s: jax.random.normal(k, shape, f32) * s
    return {
        "x": jax.random.normal(ks[0], (BATCH, SEQ, D_MODEL), f32),
        "norm1_g": 1.0 + nrm(ks[1], (DEPTH, D_MODEL), 0.02),
        "w_in": nrm(ks[2], (DEPTH, D_MODEL, IN_WIDTH), D_MODEL ** -0.5),
        "b_forget": jax.random.uniform(ks[3], (DEPTH, ATTN_HEADS), f32, 1.0, 4.0),
        "q_norm_g": 1.0 + nrm(ks[4], (DEPTH, ATTN_HEADS, HEAD_DIM), 0.02),
        "k_norm_g": 1.0 + nrm(ks[5], (DEPTH, ATTN_HEADS, HEAD_DIM), 0.02),
        "w_pool": nrm(ks[6], (DEPTH, len(POOL_WINDOWS), POOL_GROUP, POOL_GROUP), POOL_GROUP ** -0.5),
        "pool_scale": 1.0 + nrm(ks[7], (DEPTH, POOL_WIDTH), 0.02),
        "w_out": nrm(ks[8], (DEPTH, MIX_WIDTH, D_MODEL), MIX_WIDTH ** -0.5),
        "norm2_g": 1.0 + nrm(ks[9], (DEPTH, D_MODEL), 0.02),
        "w_query": nrm(ks[10], (DEPTH, D_MODEL, PEER_HEADS * PEER_QUERY), D_MODEL ** -0.5),
        "peer_sub_keys": nrm(ks[11], (DEPTH, 2, PEER_KEYS, PEER_QUERY // 2), (PEER_QUERY // 2) ** -0.5),
        "expert_u": nrm(ks[12], (DEPTH, PEER_EXPERTS, D_MODEL), D_MODEL ** -0.5),
        "expert_v": nrm(ks[13], (DEPTH, PEER_EXPERTS, D_MODEL), PEER_HEADS ** -0.5),
    }


def reference(x, norm1_g, w_in, b_forget, q_norm_g, k_norm_g, w_pool, pool_scale, w_out,
              norm2_g, w_query, peer_sub_keys, expert_u, expert_v):
    B, S, _ = x.shape
    for l in range(DEPTH):
        h = rms_norm(x, norm1_g[l])
        z = h @ w_in[l]
        o = POOL_WIDTH
        z_pool = z[..., :o]
        q = z[..., o:o + ATTN_WIDTH].reshape(B, S, ATTN_HEADS, HEAD_DIM)
        k = z[..., o + ATTN_WIDTH:o + 2 * ATTN_WIDTH].reshape(B, S, ATTN_HEADS, HEAD_DIM)
        v = z[..., o + 2 * ATTN_WIDTH:o + 3 * ATTN_WIDTH].reshape(B, S, ATTN_HEADS, HEAD_DIM)
        f_logit = z[..., o + 3 * ATTN_WIDTH:].astype(jnp.float32) + b_forget[l].astype(jnp.float32)
        log_f = jax.nn.log_sigmoid(f_logit)
        q = rms_norm(q, q_norm_g[l])
        k = rms_norm(k, k_norm_g[l])
        y_pool = pool_mixer(z_pool, w_pool[l], pool_scale[l])
        y_attn = forgetting_attention(q, k, v, log_f).reshape(B, S, ATTN_WIDTH)
        x = x + jnp.concatenate([y_pool, y_attn], axis=-1) @ w_out[l]
        x = x + peer_ffn(rms_norm(x, norm2_g[l]), w_query[l], peer_sub_keys[l], expert_u[l], expert_v[l])
    return x
```

```cpp
#include <hip/hip_runtime.h>
#include <cstdio>
#include <cstdint>
#include <cmath>

namespace {
constexpr int D = 1024, BATCH = 16, SEQ = 2048, T = BATCH * SEQ;
constexpr int POOLW = 512, ATTW = 512, NH = 8, HD = 64, INW = POOLW + 3 * ATTW + NH;
constexpr int PH = 8, PK = 128, PQ = 256, TOPK = 16;
constexpr float EPS = 1e-6f;

__device__ __forceinline__ float wave_sum(float v) {
#pragma unroll
    for (int o = 1; o < 64; o <<= 1) v += __shfl_xor(v, o);
    return v;
}

__global__ void __launch_bounds__(256) k_rmsnorm(const float* __restrict__ x, const float* __restrict__ g, float* __restrict__ out) {
    const int row = blockIdx.x * 4 + (threadIdx.x >> 6), lane = threadIdx.x & 63;
    const float4* xr = (const float4*)(x + (size_t)row * D);
    float4 v[4]; float s = 0.f;
#pragma unroll
    for (int j = 0; j < 4; ++j) { v[j] = xr[lane + 64 * j]; s += v[j].x * v[j].x + v[j].y * v[j].y + v[j].z * v[j].z + v[j].w * v[j].w; }
    const float r = rsqrtf(wave_sum(s) * (1.f / D) + EPS);
    float4* o = (float4*)(out + (size_t)row * D);
#pragma unroll
    for (int j = 0; j < 4; ++j) { const float4 gg = ((const float4*)g)[lane + 64 * j]; o[lane + 64 * j] = make_float4(v[j].x * r * gg.x, v[j].y * r * gg.y, v[j].z * r * gg.z, v[j].w * r * gg.w); }
}

__global__ void __launch_bounds__(256) k_gemm(const float* __restrict__ A, const float* __restrict__ B, float* __restrict__ C, const float* __restrict__ R, int M, int N, int K) {
    __shared__ float As[16][64 + 4], Bs[16][64 + 4];
    const int bm = blockIdx.y * 64, bn = blockIdx.x * 64, tid = threadIdx.x, tx = tid & 15, ty = tid >> 4;
    float acc[4][4] = {};
    for (int k0 = 0; k0 < K; k0 += 16) {
        { const int r = tid >> 2, c = (tid & 3) * 4; const float4 a = *(const float4*)(A + (size_t)(bm + r) * K + k0 + c);
          As[c + 0][r] = a.x; As[c + 1][r] = a.y; As[c + 2][r] = a.z; As[c + 3][r] = a.w; }
        { const int r = tid >> 4, c = (tid & 15) * 4;
#pragma unroll
          for (int i = 0; i < 4; ++i) { const int n = bn + c + i; Bs[r][c + i] = n < N ? B[(size_t)(k0 + r) * N + n] : 0.f; } }
        __syncthreads();
#pragma unroll
        for (int k = 0; k < 16; ++k) {
            float a[4], b[4];
#pragma unroll
            for (int i = 0; i < 4; ++i) { a[i] = As[k][ty * 4 + i]; b[i] = Bs[k][tx * 4 + i]; }
#pragma unroll
            for (int i = 0; i < 4; ++i)
#pragma unroll
                for (int j = 0; j < 4; ++j) acc[i][j] += a[i] * b[j];
        }
        __syncthreads();
    }
#pragma unroll
    for (int i = 0; i < 4; ++i)
#pragma unroll
        for (int j = 0; j < 4; ++j) { const int m = bm + ty * 4 + i, n = bn + tx * 4 + j; if (n < N) C[(size_t)m * N + n] = acc[i][j] + (R ? R[(size_t)m * N + n] : 0.f); }
}

__global__ void __launch_bounds__(256) k_zpost(float* __restrict__ Z, const float* __restrict__ bf, const float* __restrict__ qg, const float* __restrict__ kg, float* __restrict__ LF) {
    const int t = blockIdx.x, tid = threadIdx.x, lane = tid & 63, w = tid >> 6;
    float* z = Z + (size_t)t * INW;
    for (int gi = w; gi < 16; gi += 4) {
        const int isk = gi >> 3, h = gi & 7; float* p = z + POOLW + isk * ATTW + h * HD;
        const float v = p[lane]; const float r = rsqrtf(wave_sum(v * v) * (1.f / HD) + EPS);
        p[lane] = v * r * (isk ? kg : qg)[h * HD + lane];
    }
    if (tid < NH) { const float f = z[POOLW + 3 * ATTW + tid] + bf[tid]; LF[(size_t)t * NH + tid] = fminf(f, 0.f) - log1pf(expf(-fabsf(f))); }
}

__global__ void k_cumsum(const float* __restrict__ LF, float* __restrict__ F) {
    const int i = blockIdx.x * blockDim.x + threadIdx.x; if (i >= BATCH * NH) return;
    const int b = i / NH, h = i % NH; float a = 0.f;
    for (int s = 0; s < SEQ; ++s) { a += LF[((size_t)b * SEQ + s) * NH + h]; F[(size_t)i * SEQ + s] = a; }
}

__global__ void __launch_bounds__(256) k_pool(const float* __restrict__ Z, float* __restrict__ P) {
    const size_t i = (size_t)blockIdx.x * 256 + threadIdx.x; const int c = (int)(i % POOLW); const int t = (int)(i / POOLW), s = t % SEQ;
    const int w = 2 << (c >> 7); const int start = s + 1 - w > 0 ? s + 1 - w : 0; float a = 0.f;
    for (int j = start; j <= s; ++j) a += Z[(size_t)(t - s + j) * INW + c];
    P[i] = a / (float)(s + 1 - start) - Z[(size_t)t * INW + c];
}
__global__ void __launch_bounds__(128) k_poolmix(const float* __restrict__ P, const float* __restrict__ wp, const float* __restrict__ sc, float* __restrict__ YC) {
    __shared__ float ps[128];
    const int t = blockIdx.x, g = blockIdx.y, d = threadIdx.x;
    ps[d] = P[(size_t)t * POOLW + g * 128 + d]; __syncthreads();
    float a = 0.f;
    for (int c = 0; c < 128; ++c) a += ps[c] * wp[((size_t)g * 128 + c) * 128 + d];
    YC[(size_t)t * D + g * 128 + d] = a * sc[g * 128 + d];
}

__global__ void __launch_bounds__(256) k_attn(const float* __restrict__ Z, const float* __restrict__ F, float* __restrict__ YC) {
    __shared__ float Ks[64][HD], Vs[64][HD], Fs[64];
    const int qb = blockIdx.x, h = blockIdx.y, b = blockIdx.z, tid = threadIdx.x;
    const int qi = qb * 256 + tid; const size_t rowq = (size_t)b * SEQ + qi;
    float q[HD], o[HD];
#pragma unroll
    for (int d = 0; d < HD; ++d) { q[d] = Z[rowq * INW + POOLW + h * HD + d] * 0.125f; o[d] = 0.f; }
    const float* Fh = F + ((size_t)b * NH + h) * SEQ; const float fq = Fh[qi];
    float m = -INFINITY, l = 0.f;
    for (int k0 = 0; k0 < (qb + 1) * 256; k0 += 64) {
        __syncthreads();
        for (int i = tid; i < 64 * HD; i += 256) { const int r = i >> 6, c = i & 63; const size_t row = (size_t)b * SEQ + k0 + r;
            Ks[r][c] = Z[row * INW + POOLW + ATTW + h * HD + c]; Vs[r][c] = Z[row * INW + POOLW + 2 * ATTW + h * HD + c]; }
        if (tid < 64) Fs[tid] = Fh[k0 + tid];
        __syncthreads();
        for (int j = 0; j < 64; ++j) {
            if (k0 + j > qi) break;
            float s = 0.f;
#pragma unroll
            for (int d = 0; d < HD; ++d) s += q[d] * Ks[j][d];
            s += fq - Fs[j];
            const float mn = fmaxf(m, s), al = expf(m - mn), p = expf(s - mn);
            l = l * al + p; m = mn;
#pragma unroll
            for (int d = 0; d < HD; ++d) o[d] = o[d] * al + p * Vs[j][d];
        }
    }
    const float il = 1.f / l;
#pragma unroll
    for (int d = 0; d < HD; ++d) YC[rowq * D + POOLW + h * HD + d] = o[d] * il;
}

__global__ void k_skt(const float* __restrict__ sk, float* __restrict__ skt) {
    const int i = blockIdx.x * 256 + threadIdx.x; if (i >= 2 * 128 * 128) return;
    const int hf = i >> 14, k = (i >> 7) & 127, c = i & 127; skt[(hf * 128 + c) * 128 + k] = sk[i];
}

__global__ void __launch_bounds__(128) k_route(const float* __restrict__ QP, const float* __restrict__ skt, int* __restrict__ IDX, float* __restrict__ GATE) {
    __shared__ float qs[256], s1[128], s2[128], v1[16], v2[16], cs[256], ts[16];
    __shared__ int i1[16], i2[16], ti[16];
    const int t = blockIdx.x, h = blockIdx.y, k = threadIdx.x;
    qs[k] = QP[(size_t)t * 2048 + h * 256 + k]; qs[k + 128] = QP[(size_t)t * 2048 + h * 256 + 128 + k];
    __syncthreads();
    float a = 0.f, b = 0.f;
    for (int c = 0; c < 128; ++c) { a += qs[c] * skt[c * 128 + k]; b += qs[128 + c] * skt[(128 + c) * 128 + k]; }
    s1[k] = a; s2[k] = b; __syncthreads();
    int r1 = 0, r2 = 0;
    for (int j = 0; j < 128; ++j) { const float x = s1[j], y = s2[j]; r1 += (x > a || (x == a && j < k)); r2 += (y > b || (y == b && j < k)); }
    if (r1 < 16) { v1[r1] = a; i1[r1] = k; }
    if (r2 < 16) { v2[r2] = b; i2[r2] = k; }
    __syncthreads();
    cs[k] = v1[k >> 4] + v2[k & 15]; cs[k + 128] = v1[(k + 128) >> 4] + v2[k & 15];
    __syncthreads();
    for (int e = k; e < 256; e += 128) {
        const float c = cs[e]; int r = 0;
        for (int j = 0; j < 256; ++j) { const float x = cs[j]; r += (x > c || (x == c && j < e)); }
        if (r < 16) { ts[r] = c; ti[r] = i1[e >> 4] * 128 + i2[e & 15]; }
    }
    __syncthreads();
    if (k < 16) {
        const float mx = ts[0]; float sum = 0.f;
        for (int j = 0; j < 16; ++j) sum += expf(ts[j] - mx);
        IDX[((size_t)t * PH + h) * 16 + k] = ti[k]; GATE[((size_t)t * PH + h) * 16 + k] = expf(ts[k] - mx) / sum;
    }
}

__global__ void __launch_bounds__(256) k_experts(const float* __restrict__ H2, const int* __restrict__ IDX, const float* __restrict__ GATE,
                                                 const float* __restrict__ U, const float* __restrict__ V, float* __restrict__ out) {
    __shared__ float ys[4][D];
    const int t = blockIdx.x, tid = threadIdx.x, lane = tid & 63, w = tid >> 6;
    const float4* xr = (const float4*)(H2 + (size_t)t * D); float4 x[4], y[4];
#pragma unroll
    for (int j = 0; j < 4; ++j) { x[j] = xr[lane + 64 * j]; y[j] = make_float4(0.f, 0.f, 0.f, 0.f); }
    for (int e = 0; e < 32; ++e) {
        const int slot = w * 32 + e; const int ex = IDX[(size_t)t * 128 + slot]; const float g = GATE[(size_t)t * 128 + slot];
        const float4* ur = (const float4*)(U + (size_t)ex * D); float s = 0.f;
#pragma unroll
        for (int j = 0; j < 4; ++j) { const float4 u = ur[lane + 64 * j]; s += u.x * x[j].x + u.y * x[j].y + u.z * x[j].z + u.w * x[j].w; }
        s = wave_sum(s);
        const float a = 0.5f * s * (1.f + erff(s * 0.70710678118654752f)) * g;
        const float4* vr = (const float4*)(V + (size_t)ex * D);
#pragma unroll
        for (int j = 0; j < 4; ++j) { const float4 v = vr[lane + 64 * j]; y[j].x += a * v.x; y[j].y += a * v.y; y[j].z += a * v.z; y[j].w += a * v.w; }
    }
#pragma unroll
    for (int j = 0; j < 4; ++j) ((float4*)ys[w])[lane + 64 * j] = y[j];
    __syncthreads();
    for (int i = tid; i < D; i += 256) out[(size_t)t * D + i] += ys[0][i] + ys[1][i] + ys[2][i] + ys[3][i];
}
}

extern "C" void kernel_launch(void* const* d_in, const int* in_sizes, int n_in, void* d_out, int out_size, void* d_ws, size_t ws_size, hipStream_t stream) {
    const float* x = (const float*)d_in[0]; const float* n1g = (const float*)d_in[1]; const float* w_in = (const float*)d_in[2]; const float* bfg = (const float*)d_in[3];
    const float* qg = (const float*)d_in[4]; const float* kg = (const float*)d_in[5]; const float* wpool = (const float*)d_in[6]; const float* pscale = (const float*)d_in[7];
    const float* w_out = (const float*)d_in[8]; const float* n2g = (const float*)d_in[9]; const float* w_query = (const float*)d_in[10]; const float* sk = (const float*)d_in[11];
    const float* eu = (const float*)d_in[12]; const float* ev = (const float*)d_in[13]; float* out = (float*)d_out;
    char* ws = (char*)d_ws; const size_t MiB = 1u << 20;
    float* H = (float*)(ws);
    float* Z = (float*)(ws + 128 * MiB);
    float* P = (float*)(ws + 388 * MiB);
    int* IDX = (int*)(ws + 452 * MiB);
    float* GATE = (float*)(ws + 468 * MiB);
    float* LF = (float*)(ws + 484 * MiB);
    float* F = (float*)(ws + 485 * MiB);
    float* SKT = (float*)(ws + 486 * MiB);
    if (ws_size < 487 * MiB) { fprintf(stderr, "ws too small\n"); return; }
    k_rmsnorm<<<T / 4, 256, 0, stream>>>(x, n1g, H);
    k_gemm<<<dim3((INW + 63) / 64, T / 64), 256, 0, stream>>>(H, w_in, Z, nullptr, T, INW, D);
    k_zpost<<<T, 256, 0, stream>>>(Z, bfg, qg, kg, LF);
    k_cumsum<<<1, 128, 0, stream>>>(LF, F);
    k_pool<<<T * POOLW / 256, 256, 0, stream>>>(Z, P);
    float* YC = H;
    k_poolmix<<<dim3(T, 4), 128, 0, stream>>>(P, wpool, pscale, YC);
    k_attn<<<dim3(SEQ / 256, NH, BATCH), 256, 0, stream>>>(Z, F, YC);
    k_gemm<<<dim3(D / 64, T / 64), 256, 0, stream>>>(YC, w_out, out, x, T, D, D);
    float* H2 = H;
    k_rmsnorm<<<T / 4, 256, 0, stream>>>(out, n2g, H2);
    float* QP = Z;
    k_gemm<<<dim3(2048 / 64, T / 64), 256, 0, stream>>>(H2, w_query, QP, nullptr, T, 2048, D);
    k_skt<<<128, 256, 0, stream>>>(sk, SKT);
    k_route<<<dim3(T, PH), 128, 0, stream>>>(QP, SKT, IDX, GATE);
    k_experts<<<T, 256, 0, stream>>>(H2, IDX, GATE, eu, ev, out);
}
```

```cpp
#include <hip/hip_runtime.h>
#include <cstdio>
#include <cstdint>
#include <cmath>
namespace pg8 {
#define PG8_LAS __attribute__((address_space(3)))
typedef unsigned short bf16_t;
typedef short bf16x8 __attribute__((ext_vector_type(8)));
typedef float f32x4 __attribute__((ext_vector_type(4)));
typedef unsigned u32x4 __attribute__((ext_vector_type(4)));
constexpr int BM = 256, BK = 64, HALF = 128, HTB = HALF * BK * 2  , STAGE_BYTES = 8 * HTB, NXCD = 8, WGM = 8;

__host__ __device__ __forceinline__ int lds_byte(int r, int c) { const int st = (r >> 4) * 2 + (c >> 5), rr = r & 15, cc = c & 31, ob = rr * 64 + cc * 2; return st * 1024 + (ob ^ (((ob >> 9) & 1) << 5)); }
__host__ __device__ __forceinline__ void stage_rc(int b, int& R, int& C) { const int st = b / 1024, sb = b % 1024, swz = sb ^ (((sb >> 9) & 1) << 5); R = (st >> 1) * 16 + swz / 64; C = (st & 1) * 32 + (swz % 64) / 2; }
__host__ __device__ __forceinline__ int perm32(int rho) { const int n = rho >> 4, i = rho & 15; return 8 * (i >> 2) + 4 * n + (i & 3); }

struct Unit { int pm, pn; };
struct Gemm { const bf16_t* A; const bf16_t* Bt; int M, N, K; };

struct StaticOrder {
    int nM, nN, nwg, G, c;
    __host__ __device__ void init(int M, int N, int G_, int c_) { nM = M / BM; nN = N / BM; nwg = nM * nN; G = G_; c = c_; }
    __host__ __device__ bool next(int i, Unit& u) const {
        const long L = (long)i * G + c; if (L >= nwg) return false;
        int wgid = (int)L; { const int q = nwg / NXCD, r = nwg % NXCD, xcd = wgid % NXCD, off = wgid / NXCD; wgid = (xcd < r ? xcd * (q + 1) : r * (q + 1) + (xcd - r) * q) + off; }
        const int nig = WGM * nN, gid = wgid / nig, fm = gid * WGM, gsz = (nM - fm) < WGM ? (nM - fm) : WGM;
        u.pm = fm + ((wgid % nig) % gsz); u.pn = (wgid % nig) / gsz; return true;
    }
    __device__ __forceinline__ void a_ready(const Unit&) const {}
    __device__ __forceinline__ void done(const Unit&) const {}
};

__device__ __forceinline__ unsigned cvt_pk_bf16(float lo, float hi) { unsigned r; asm volatile("v_cvt_pk_bf16_f32 %0, %1, %2" : "=v"(r) : "v"(lo), "v"(hi)); return r; }
typedef float f32x2 __attribute__((ext_vector_type(2)));
__device__ __forceinline__ f32x2 gelu_pk(f32x2 v) {
    const f32x2 av = __builtin_elementwise_abs(v), d = av * 0.2316418882f + 1.0f;
    f32x2 t; t.x = __builtin_amdgcn_rcpf(d.x); t.y = __builtin_amdgcn_rcpf(d.y);
    f32x2 q = t * 0.5307027145f + (-0.7265760135f); q = q * t + 0.7107068705f; q = q * t + (-0.142248368f); q = q * t + 0.127414796f; q = q * t;
    const f32x2 s = (v * v) * (-0.72134752044f);
    f32x2 e; e.x = __builtin_amdgcn_exp2f(s.x); e.y = __builtin_amdgcn_exp2f(s.y);
    const f32x2 m = v * (q * e), r = v - m;
    f32x2 o; o.x = v.x < 0.f ? m.x : r.x; o.y = v.y < 0.f ? m.y : r.y; return o;
}

template <int ACT  > struct EpiBf16 {
    static constexpr bool PERM = true, AFTER_DRAIN = false; static_assert(ACT == 0 || ACT == 1, "EpiBf16: ACT is 0 (none) or 1 (gelu_pk)");
    bf16_t* O; int ldc; const float* bias; int split_cols; size_t split_stride; float scale0;
    __device__ __forceinline__ void operator()(const f32x4 (&acc)[2][2][4][2], const Unit& u, int wr, int wc, int fr, int fq) const {
        const int row0 = u.pm * BM + wr * 64 + fr; int colt = u.pn * BM; bf16_t* base = O;
        float sc = 1.f; if (split_cols) { const int t = colt / split_cols; base += (size_t)t * split_stride; colt -= t * split_cols; if (t == 0) sc = scale0; }
        const int col0 = colt + wc * 32 + 8 * fq, bcol0 = u.pn * BM + wc * 32 + 8 * fq;
        f32x4 bv[2][2];
#pragma unroll
        for (int bj = 0; bj < 2; ++bj)
#pragma unroll
            for (int n = 0; n < 2; ++n) bv[bj][n] = bias ? *(const f32x4*)(bias + bcol0 + bj * HALF + 4 * n) : (f32x4){0.f, 0.f, 0.f, 0.f};
#pragma unroll
        for (int ai = 0; ai < 2; ++ai)
#pragma unroll
            for (int m = 0; m < 4; ++m) { bf16_t* rowp = base + (size_t)(row0 + ai * HALF + m * 16) * ldc + col0;
#pragma unroll
                for (int bj = 0; bj < 2; ++bj) { f32x4 v0 = acc[ai][bj][m][0] + bv[bj][0], v1 = acc[ai][bj][m][1] + bv[bj][1];
                    if (ACT == 1) { f32x2 a = gelu_pk((f32x2){v0[0], v0[1]}), b = gelu_pk((f32x2){v0[2], v0[3]}), c = gelu_pk((f32x2){v1[0], v1[1]}), d = gelu_pk((f32x2){v1[2], v1[3]});
                        v0 = (f32x4){a.x, a.y, b.x, b.y}; v1 = (f32x4){c.x, c.y, d.x, d.y}; }
                    v0 = v0 * sc; v1 = v1 * sc; u32x4 w; w.x = cvt_pk_bf16(v0[0], v0[1]); w.y = cvt_pk_bf16(v0[2], v0[3]); w.z = cvt_pk_bf16(v1[0], v1[1]); w.w = cvt_pk_bf16(v1[2], v1[3]);
                    *(u32x4*)(rowp + bj * HALF) = w; } }
    }
};
template <class Epi, class Sched, bool ALIGN_EPI = false, bool SP2 = false>
__device__ __forceinline__ void gemm_phase(PG8_LAS unsigned char* lds, const Gemm g, const Sched& S, const Epi& E) {
    int tid_ = threadIdx.x; asm volatile("" : "+v"(tid_));
    const int tid = tid_, wid = __builtin_amdgcn_readfirstlane(tid >> 6), lane = tid & 63, wr = wid >> 2, wc = wid & 3, fr = lane & 15, fq = lane >> 4;
    const int K = g.K, nt = K / BK;
    unsigned voffA[2], voffB[2];
#pragma unroll
    for (int i = 0; i < 2; ++i) { int R, C; stage_rc(tid * 16 + i * 8192, R, C); const int Rb = Epi::PERM ? ((R & ~31) + perm32(R & 31)) : R;
        voffA[i] = (unsigned)(R * K + C) * 2u; voffB[i] = (unsigned)(Rb * K + C) * 2u; }
    const size_t kstep = (size_t)(BK * 2);
    const size_t hstep = (size_t)HALF * K * 2;
    const size_t tstep = 2 * hstep;
    const unsigned ldsw = (unsigned)wid * 1024u;
    const int aoff = lds_byte(wr * 64 + fr, fq * 8), boff = lds_byte(wc * 32 + fr, fq * 8);
#define PG8_SA(b, h) (((b) * 2 + (h)) * HTB)
#define PG8_SB(b, h) ((4 + (b) * 2 + (h)) * HTB)
#define PG8_STAGE(bufoff, gbase, voff) do { _Pragma("unroll") for (int _i = 0; _i < 2; ++_i) \
        __builtin_amdgcn_global_load_lds((const unsigned*)((const char*)(gbase) + (voff)[_i]), (PG8_LAS unsigned*)(lds + (bufoff) + ldsw + _i * 8192), 16, 0, 0); } while (0)
#define PG8_LDA(dst, b, h) do { _Pragma("unroll") for (int m = 0; m < 4; ++m) _Pragma("unroll") for (int k = 0; k < 2; ++k) dst[m][k] = *(const PG8_LAS bf16x8*)(lds + PG8_SA(b, h) + aoff + m * 2048 + k * 1024); } while (0)
#define PG8_LDB(dst, b, h) do { _Pragma("unroll") for (int n = 0; n < 2; ++n) _Pragma("unroll") for (int k = 0; k < 2; ++k) dst[n][k] = *(const PG8_LAS bf16x8*)(lds + PG8_SB(b, h) + boff + n * 2048 + k * 1024); } while (0)
#define PG8_MMA(ai, bj, At, Bt) do { __builtin_amdgcn_s_setprio(1); _Pragma("unroll") for (int m = 0; m < 4; ++m) _Pragma("unroll") for (int n = 0; n < 2; ++n) _Pragma("unroll") for (int k = 0; k < 2; ++k) \
        acc[ai][bj][m][n] = __builtin_amdgcn_mfma_f32_16x16x32_bf16(Bt[n][k], At[m][k], acc[ai][bj][m][n], 0, 0, 0); __builtin_amdgcn_s_setprio(0); } while (0)
#define PG8_WAIT_V(n) asm volatile("s_waitcnt vmcnt(" #n ")" ::: "memory")
#define PG8_WAIT_L(n) asm volatile("s_waitcnt lgkmcnt(" #n ")" ::: "memory")
#define PG8_BAR __builtin_amdgcn_s_barrier()
#define PG8_SCHED __builtin_amdgcn_sched_barrier(0)
    Unit cur, nxt; int ui = 0;
    if (!S.next(0, cur)) return;
    f32x4 acc[2][2][4][2];
#pragma unroll
    for (int a = 0; a < 2; ++a)
#pragma unroll
        for (int b = 0; b < 2; ++b)
#pragma unroll
            for (int m = 0; m < 4; ++m)
#pragma unroll
                for (int n = 0; n < 2; ++n) acc[a][b][m][n] = (f32x4){0.f, 0.f, 0.f, 0.f};
    bf16x8 At[4][2], B0[2][2], B1[2][2];
    const char* cA = (const char*)g.A + (size_t)cur.pm * tstep; const char* cB = (const char*)g.Bt + (size_t)cur.pn * tstep;
    S.a_ready(cur);
    if constexpr (SP2) {
        PG8_STAGE(PG8_SB(0, 0), cB, voffB); PG8_STAGE(PG8_SB(0, 1), cB + hstep, voffB); PG8_STAGE(PG8_SA(0, 0), cA, voffA); PG8_STAGE(PG8_SA(0, 1), cA + hstep, voffA);
        if (wr == 1) PG8_BAR;
        PG8_WAIT_V(2); PG8_BAR;
        PG8_STAGE(PG8_SB(1, 0), cB + kstep, voffB); PG8_STAGE(PG8_SA(1, 0), cA + kstep, voffA); PG8_STAGE(PG8_SB(1, 1), cB + hstep + kstep, voffB);
        PG8_WAIT_V(6); PG8_BAR;
    } else {
        PG8_STAGE(PG8_SB(0, 0), cB, voffB); PG8_STAGE(PG8_SA(0, 0), cA, voffA); PG8_STAGE(PG8_SB(0, 1), cB + hstep, voffB); PG8_STAGE(PG8_SA(0, 1), cA + hstep, voffA);
        if (wr == 1) PG8_BAR;
        PG8_WAIT_V(4); PG8_BAR;
        PG8_STAGE(PG8_SB(1, 0), cB + kstep, voffB); PG8_STAGE(PG8_SA(1, 0), cA + kstep, voffA); PG8_STAGE(PG8_SB(1, 1), cB + hstep + kstep, voffB);
        PG8_WAIT_V(6); PG8_BAR;
    }
    for (;;) {
        const bool has_next = S.next(ui + 1, nxt);
        const char* nA = has_next ? (const char*)g.A + (size_t)nxt.pm * tstep : cA; const char* nB = has_next ? (const char*)g.Bt + (size_t)nxt.pn * tstep : cB;
        for (int t = 0; t < nt; t += 2) {
            const bool last = (t == nt - 2);
            const char* a1 = cA + (size_t)(t + 1) * kstep;
            const char* a2 = last ? nA : cA + (size_t)(t + 2) * kstep; const char* b2 = last ? nB : cB + (size_t)(t + 2) * kstep;
            const char* a3 = a2 + kstep; const char* b3 = b2 + kstep;
            if (last && has_next) S.a_ready(nxt);
            if constexpr (SP2) {
            PG8_LDB(B0, 0, 0); PG8_LDB(B1, 0, 1); PG8_SCHED; PG8_LDA(At, 0, 0); PG8_STAGE(PG8_SA(1, 1), a1 + hstep, voffA);
            PG8_WAIT_V(8); PG8_WAIT_L(0); PG8_BAR; PG8_MMA(0, 0, At, B0); PG8_MMA(0, 1, At, B1); PG8_BAR; PG8_SCHED;
            PG8_LDA(At, 0, 1); PG8_STAGE(PG8_SB(0, 0), b2, voffB); PG8_STAGE(PG8_SB(0, 1), b2 + hstep, voffB); PG8_STAGE(PG8_SA(0, 0), a2, voffA);
            PG8_WAIT_V(8); PG8_WAIT_L(0); PG8_BAR; PG8_MMA(1, 0, At, B0); PG8_MMA(1, 1, At, B1); PG8_BAR; PG8_SCHED;
            PG8_LDB(B0, 1, 0); PG8_LDB(B1, 1, 1); PG8_SCHED; PG8_LDA(At, 1, 0); PG8_STAGE(PG8_SA(0, 1), a2 + hstep, voffA);
            PG8_WAIT_V(8); PG8_WAIT_L(0); PG8_BAR; PG8_MMA(0, 0, At, B0); PG8_MMA(0, 1, At, B1); PG8_BAR; PG8_SCHED;
            PG8_LDA(At, 1, 1); PG8_STAGE(PG8_SB(1, 0), b3, voffB); PG8_STAGE(PG8_SB(1, 1), b3 + hstep, voffB); PG8_STAGE(PG8_SA(1, 0), a3, voffA);
            PG8_WAIT_V(8); PG8_WAIT_L(0); PG8_BAR; PG8_MMA(1, 0, At, B0); PG8_MMA(1, 1, At, B1); PG8_BAR; PG8_SCHED;
            } else {
            PG8_LDB(B0, 0, 0); PG8_SCHED; PG8_LDA(At, 0, 0); PG8_STAGE(PG8_SA(1, 1), a1 + hstep, voffA);
            PG8_WAIT_L(8); PG8_BAR; PG8_WAIT_L(0); PG8_MMA(0, 0, At, B0); PG8_BAR; PG8_SCHED;
            PG8_LDB(B1, 0, 1); PG8_STAGE(PG8_SB(0, 0), b2, voffB);
            PG8_BAR; PG8_WAIT_L(0); PG8_MMA(0, 1, At, B1); PG8_BAR;
            PG8_LDA(At, 0, 1); PG8_STAGE(PG8_SA(0, 0), a2, voffA);
            PG8_BAR; PG8_WAIT_L(0); PG8_MMA(1, 0, At, B0); PG8_BAR; PG8_SCHED;
            PG8_STAGE(PG8_SB(0, 1), b2 + hstep, voffB);
            PG8_WAIT_V(6); PG8_BAR; PG8_MMA(1, 1, At, B1); PG8_BAR;
            PG8_LDB(B0, 1, 0); PG8_SCHED; PG8_LDA(At, 1, 0); PG8_STAGE(PG8_SA(0, 1), a2 + hstep, voffA);
            PG8_WAIT_L(8); PG8_BAR; PG8_WAIT_L(0); PG8_MMA(0, 0, At, B0); PG8_BAR; PG8_SCHED;
            PG8_LDB(B1, 1, 1); PG8_STAGE(PG8_SB(1, 0), b3, voffB);
            PG8_BAR; PG8_WAIT_L(0); PG8_MMA(0, 1, At, B1); PG8_BAR;
            PG8_LDA(At, 1, 1); PG8_STAGE(PG8_SA(1, 0), a3, voffA);
            PG8_BAR; PG8_WAIT_L(0); PG8_MMA(1, 0, At, B0); PG8_BAR; PG8_SCHED;
            PG8_STAGE(PG8_SB(1, 1), b3 + hstep, voffB);
            PG8_WAIT_V(6); PG8_BAR; PG8_MMA(1, 1, At, B1); PG8_BAR;
            }
        }
        if constexpr (ALIGN_EPI) { if (wr == 0) PG8_BAR; }
        if constexpr (!Epi::AFTER_DRAIN) { E(acc, cur, wr, wc, fr, fq); S.done(cur); }
        if (!has_next) break;
#pragma unroll
        for (int a = 0; a < 2; ++a)
#pragma unroll
            for (int b = 0; b < 2; ++b)
#pragma unroll
                for (int m = 0; m < 4; ++m)
#pragma unroll
                    for (int n = 0; n < 2; ++n) acc[a][b][m][n] = (f32x4){0.f, 0.f, 0.f, 0.f};
        cur = nxt; cA = nA; cB = nB; ++ui;
        if constexpr (ALIGN_EPI) { if (wr == 1) PG8_BAR; }
    }
    PG8_WAIT_V(0);
    if constexpr (!ALIGN_EPI) { if (wr == 0) PG8_BAR; }
    PG8_BAR;
    if constexpr (Epi::AFTER_DRAIN) { E.fused(acc, cur, wr, wc, fr, fq, lds, wid, lane); S.done(cur); }
#undef PG8_SA
#undef PG8_SB
#undef PG8_STAGE
#undef PG8_LDA
#undef PG8_LDB
#undef PG8_MMA
#undef PG8_WAIT_V
#undef PG8_WAIT_L
#undef PG8_BAR
#undef PG8_SCHED
}
}
#include <hip/hip_bf16.h>
#include <cmath>
namespace attn_body {
using bf16=__hip_bfloat16;
using bf16x8=__attribute__((ext_vector_type(8)))short;
using s16x4=__attribute__((ext_vector_type(4)))short;
using f32x16=__attribute__((ext_vector_type(16)))float;
using u32x4=__attribute__((ext_vector_type(4)))unsigned;
using f32x4=__attribute__((ext_vector_type(4)))float;
constexpr int BATCH=16,NHEAD=8,SEQ=2048,D=64,DM=NHEAD*D,OPITCH=1024,OCOL=512;
constexpr int NW=8,QBLK=32,QB=QBLK*NW,KVBLK=64,NQB=SEQ/QB;
constexpr int ATTN_PITCH=DM, ATTN_UNIT_ROWS=QB;
__device__ __forceinline__ int crow(int r,int hi){return (r&3)+8*(r>>2)+4*hi;}
#define SBAR() __builtin_amdgcn_sched_barrier(0)
__device__ __forceinline__ void cmask(f32x16&p0,f32x16&p1,int jb,int qrel,int hi){
  const float NEG=-INFINITY; int kb=64*jb+4*hi;
  #pragma unroll
  for(int r=0;r<16;++r){int kv=kb+(r&3)+8*(r>>2); if(kv>qrel)p0[r]=NEG; if(kv+32>qrel)p1[r]=NEG;}
}

constexpr int NSLOT=3, SLOTB=8192;
constexpr int LDS_K=0, LDS_V=NSLOT*SLOTB, LDS_WS=2*NSLOT*SLOTB, LDS_OST=LDS_WS+NW*64*4, LDS_BIAS=LDS_OST+NW*4096, LDS_BYTES=LDS_BIAS+SEQ*4;
constexpr float C2=0.125f*1.4426950408889634f;
__device__ __forceinline__ void glds16(const void*gsrc,unsigned lds_dst){unsigned keep;
  asm volatile("s_mov_b32 %0, m0\n\ts_mov_b32 m0, %2\n\ts_nop 0\n\tglobal_load_lds_dwordx4 %1, off\n\ts_mov_b32 m0, %0":"=&s"(keep):"v"(gsrc),"s"(lds_dst):"memory");}
__device__ __forceinline__ float max3f(float a,float b,float c){float r;asm("v_max3_f32 %0, %1, %2, %3":"=v"(r):"v"(a),"v"(b),"v"(c));return r;}
__device__ __forceinline__ float max2f(float a,float b){float r;asm("v_max_f32_e32 %0, %1, %2":"=v"(r):"v"(a),"v"(b));return r;}
__device__ __forceinline__ float fadd_s(float a,float b){float r;asm("v_add_f32_e32 %0, %1, %2":"=v"(r):"v"(a),"v"(b));return r;}
__device__ __forceinline__ float fsub_s(float a,float b){float r;asm("v_sub_f32_e32 %0, %1, %2":"=v"(r):"v"(a),"v"(b));return r;}
typedef float f32x2_t __attribute__((ext_vector_type(2))); typedef __bf16 bf16x2_t __attribute__((ext_vector_type(2)));
__device__ __forceinline__ unsigned cvtpk_s(float lo,float hi){f32x2_t v={lo,hi};bf16x2_t b=__builtin_convertvector(v,bf16x2_t);return __builtin_bit_cast(unsigned,b);}
#define WAIT_BAR(N) asm volatile("s_waitcnt vmcnt(" #N ") lgkmcnt(0)\n\ts_barrier":::"memory")

__device__ __forceinline__ void qkt(f32x16&p0,f32x16&p1,const char*Kslot,const bf16x8*qr,int r32,int hi){
  const char*kb=Kslot+hi*1024+r32*16;
  #pragma unroll
  for(int d0=0;d0<4;++d0){
    const bf16x8 b0=*reinterpret_cast<const bf16x8*>(kb+d0*2048);
    const bf16x8 b1=*reinterpret_cast<const bf16x8*>(kb+d0*2048+512);
    {p0=__builtin_amdgcn_mfma_f32_32x32x16_bf16(b0,qr[d0],p0,0,0,0);p1=__builtin_amdgcn_mfma_f32_32x32x16_bf16(b1,qr[d0],p1,0,0,0);}}
}
typedef __attribute__((address_space(3))) const char* lds_cptr;
typedef short v4i16_t __attribute__((ext_vector_type(4)));
__device__ __forceinline__ void kload8(bf16x8*kf,lds_cptr kp){
  kf[0]=*(const __attribute__((address_space(3))) bf16x8*)(kp);      kf[1]=*(const __attribute__((address_space(3))) bf16x8*)(kp+512);
  kf[2]=*(const __attribute__((address_space(3))) bf16x8*)(kp+2048); kf[3]=*(const __attribute__((address_space(3))) bf16x8*)(kp+2560);
  kf[4]=*(const __attribute__((address_space(3))) bf16x8*)(kp+4096); kf[5]=*(const __attribute__((address_space(3))) bf16x8*)(kp+4608);
  kf[6]=*(const __attribute__((address_space(3))) bf16x8*)(kp+6144); kf[7]=*(const __attribute__((address_space(3))) bf16x8*)(kp+6656);
}
__device__ __forceinline__ void kload2(bf16x8*kf,lds_cptr kp,int j){ kf[2*j]=*(const __attribute__((address_space(3))) bf16x8*)(kp+j*2048); kf[2*j+1]=*(const __attribute__((address_space(3))) bf16x8*)(kp+j*2048+512); }
__device__ __forceinline__ s16x4 vtr(lds_cptr p){ return __builtin_bit_cast(s16x4,__builtin_amdgcn_ds_read_tr16_b64_v4i16((__attribute__((address_space(3))) v4i16_t*)p)); }
__device__ __forceinline__ float rowmax(const f32x16&p0,const f32x16&p1){
  float a=max3f(p0[0],p0[1],p1[0]),b=max3f(p0[2],p0[3],p1[1]);a=max3f(a,p1[2],p1[3]);
  #pragma unroll
  for(int r=4;r<16;r+=4){a=max3f(a,p0[r],p0[r+1]);b=max3f(b,p0[r+2],p0[r+3]);a=max3f(a,p1[r],p1[r+1]);b=max3f(b,p1[r+2],p1[r+3]);}
  const float m=max2f(a,b);
  auto rr=__builtin_amdgcn_permlane32_swap(__float_as_uint(m),__float_as_uint(m),false,false);
  return max2f(__uint_as_float(rr[0]),__uint_as_float(rr[1]));
}
__device__ __forceinline__ void pv(f32x16*o,int vb,bf16x8 pa0,bf16x8 pa1,bf16x8 pa2,bf16x8 pa3){
  #pragma unroll
  for(int d0=0;d0<2;++d0){s16x4 lo[4],hi[4];
    #pragma unroll
    for(int ks=0;ks<4;++ks){
      asm volatile("ds_read_b64_tr_b16 %0,%1 offset:%c2":"=&v"(lo[ks]):"v"(vb),"i"(d0*4096+ks*1024):"memory");
      asm volatile("ds_read_b64_tr_b16 %0,%1 offset:%c2":"=&v"(hi[ks]):"v"(vb),"i"(d0*4096+ks*1024+512):"memory");}
    asm volatile("s_waitcnt lgkmcnt(0)":::"memory");SBAR();
    #define PK(k) (bf16x8){lo[k][0],lo[k][1],lo[k][2],lo[k][3],hi[k][0],hi[k][1],hi[k][2],hi[k][3]}
    o[d0]=__builtin_amdgcn_mfma_f32_32x32x16_bf16(pa0,PK(0),o[d0],0,0,0);
    o[d0]=__builtin_amdgcn_mfma_f32_32x32x16_bf16(pa1,PK(1),o[d0],0,0,0);
    o[d0]=__builtin_amdgcn_mfma_f32_32x32x16_bf16(pa2,PK(2),o[d0],0,0,0);
    o[d0]=__builtin_amdgcn_mfma_f32_32x32x16_bf16(pa3,PK(3),o[d0],0,0,0);
    #undef PK
  }
}

#ifndef ATTN_STORE16
#define ATTN_STORE16(p,v) (*(u32x4*)(p)=(v))
#endif
template<int THRL> __device__ __forceinline__ void attn_unit(int b,int h,int qb,const bf16*Q,const bf16*__restrict__ K,const bf16*__restrict__ V,bf16*O,const float*__restrict__ FBh,float qkmax,unsigned*ctr,char*shm){
  int tid_=threadIdx.x; asm volatile("":"+v"(tid_));
  const int tid=tid_,lane=tid&63,r32=lane&31,hi=lane>>5; const int wid=__builtin_amdgcn_readfirstlane(tid>>6);
  const long rowbase=(long)b*SEQ; const int q0=qb*QB;
  const bf16*Qw=Q+(rowbase+q0+wid*QBLK)*DM+h*D;
  const int NT0=(q0+QB)/KVBLK; int ts;
  { const float bq0=FBh[q0]; const float be=FBh[64*(lane<NT0?lane:NT0-1)+63]; const unsigned long long mk=__ballot(lane<NT0&&(bq0-be>150.f));
    ts=__builtin_popcountll(mk)&~1; ts=ts<NT0-4?ts:NT0-4; ts=__builtin_amdgcn_readfirstlane(ts); }
  const bf16*Kh=K+(rowbase+(long)ts*KVBLK)*DM+h*D,*Vh=V+(rowbase+(long)ts*KVBLK)*DM+h*D;
  const unsigned lds0=(unsigned)(uintptr_t)shm;
  float*wsf=(float*)(shm+LDS_WS)+wid*64;
  const bf16*ksrc=Kh+(long)lane*DM+wid*8;
  const bf16*vsrc=Vh+(long)(16*(wid&3)+(lane>>2))*DM+(wid>>2)*32+(lane&3)*8;
  const unsigned kdst=lds0+LDS_K+wid*1024, vdst=lds0+LDS_V+wid*1024;
  #define DMA_K(t,slot) glds16(ksrc+(long)(t)*KVBLK*DM,(unsigned)__builtin_amdgcn_readfirstlane(kdst+(slot)))
  #define DMA_V(t,slot) glds16(vsrc+(long)(t)*KVBLK*DM,(unsigned)__builtin_amdgcn_readfirstlane(vdst+(slot)))
  const int vb0=(int)(lds0+LDS_V)+((lane>>4)&1)*32+(lane&3)*8+(4*hi+((lane&15)>>2))*64;
  const char*Kbase=shm+LDS_K; bf16x8 kf[8];
  const lds_cptr shm3=(lds_cptr)shm; const lds_cptr kp0=shm3+LDS_K+hi*1024+r32*16; const lds_cptr vp0=shm3+LDS_V+((lane>>4)&1)*32+(lane&3)*8+(4*hi+((lane&15)>>2))*64;
  const int NT=NT0-ts;
  DMA_K(0,0);DMA_V(0,0);DMA_K(1,SLOTB);
  bf16x8 qr[4];
  #pragma unroll
  for(int d0=0;d0<4;++d0)qr[d0]=*reinterpret_cast<const bf16x8*>(&Qw[(long)r32*DM+d0*16+hi*8]);
  { float*bl=(float*)(shm+LDS_BIAS); int t4=tid; asm volatile("":"+v"(t4)); t4*=4;
    if(t4<q0+QB){ const f32x4 v_=*reinterpret_cast<const f32x4*>(FBh+t4); *reinterpret_cast<f32x4*>(bl+t4)=v_; } }
  const lds_cptr bp0=shm3+LDS_BIAS+16*hi+256*ts;
  #define BIASC(C0,C1,t) do{ const lds_cptr bp_=bp0+256*(t); _Pragma("unroll") for(int g_=0;g_<4;++g_){ \
    const f32x4 a_=*(const __attribute__((address_space(3))) f32x4*)(bp_+32*g_); const f32x4 b_=*(const __attribute__((address_space(3))) f32x4*)(bp_+128+32*g_); \
    C0[4*g_]=a_[0]; C0[4*g_+1]=a_[1]; C0[4*g_+2]=a_[2]; C0[4*g_+3]=a_[3]; C1[4*g_]=b_[0]; C1[4*g_+1]=b_[1]; C1[4*g_+2]=b_[2]; C1[4*g_+3]=b_[3]; } }while(0)
  float mhat=0.f,l_reg=0.f;f32x16 o[2];o[0]=f32x16{};o[1]=f32x16{};
  const int qrel=wid*QBLK+r32;
  #define CMASK(P0,P1,t) do{int jb_=(t)-(NT-4); if(jb_>=0)cmask(P0,P1,jb_,qrel,hi);}while(0)
  bool resc=false;
  #define START(P0,P1) do{ resc=false; \
    { const float dl=mhat; \
      _Pragma("unroll") for(int r=0;r<16;++r){P0[r]=fsub_s(P0[r],dl);P1[r]=fsub_s(P1[r],dl);} \
      } \
    _Pragma("unroll") for(int r=0;r<16;++r)P0[r]=__builtin_amdgcn_exp2f(P0[r]); }while(0)
  #define RESC() do{ if(resc){ asm volatile("s_waitcnt lgkmcnt(0)":::"memory"); \
      _Pragma("unroll") for(int d_=0;d_<2;++d_) _Pragma("unroll") for(int r=0;r<16;++r)o[d_][r]*=wsf[crow(r,hi)]; } }while(0)
  f32x16 pA0,pA1,pB0,pB1;
  int sl_prev=0,sl_cur=0,sl_next=SLOTB;
  #define ROT() do{sl_prev=sl_cur;sl_cur=sl_next;sl_next=(sl_next==(NSLOT-1)*SLOTB)?0:sl_next+SLOTB;}while(0)
  DMA_K(2,2*SLOTB);
  WAIT_BAR(3);
  mhat=((const float*)(shm+LDS_BIAS))[q0+qrel]+qkmax;
  BIASC(pA0,pA1,0); qkt(pA0,pA1,Kbase,qr,r32,hi);asm volatile("s_nop 15\n\ts_nop 7":"+v"(pA0),"+v"(pA1));CMASK(pA0,pA1,0);
  START(pA0,pA1);
  _Pragma("unroll") for(int r=0;r<16;++r)pA1[r]=__builtin_amdgcn_exp2f(pA1[r]);
  WAIT_BAR(0);
  DMA_K(3,0);DMA_V(1,SLOTB);
  ROT();
  kload8(kf,kp0+sl_cur);
  WAIT_BAR(2);
  s16x4 vlo[8],vhi[8]; u32x4 pw0,pw1,pw2,pw3;
  #define PKW(P,B) cvtpk_s(P[B],P[B+1])
  #define PAF(k) __builtin_bit_cast(bf16x8,pw##k)
  #define VFR(i) (bf16x8){vlo[i][0],vlo[i][1],vlo[i][2],vlo[i][3],vhi[i][0],vhi[i][1],vhi[i][2],vhi[i][3]}
  #define PIN(x) asm volatile("":"+v"(x))
  #define MX3(a,b,c) __builtin_fmaxf(__builtin_fmaxf((a),(b)),(c))
  #define GAPA(MF,A0,A1,A2,A3,W0,W1,PW) do{ MF; sacc+=A0; sacc+=A1; sacc+=A2; sacc+=A3; PIN(sacc); W0; W1; PIN(PW); SBAR(); }while(0)
  #define EX(v) __builtin_amdgcn_exp2f(v)
  #define GAPB(MF,X,B) do{ MF; X[B]=EX(X[B]-mhat); X[B+1]=EX(X[B+1]-mhat); X[B+2]=EX(X[B+2]-mhat); X[B+3]=EX(X[B+3]-mhat); PIN(X); SBAR(); }while(0)
  #define VRD(i) do{ vlo[i]=vtr(vp_+(((i)>>2)*4096+((i)&3)*1024)); vhi[i]=vtr(vp_+(((i)>>2)*4096+((i)&3)*1024+512)); }while(0)
  #define KRD(G,j) do{ if(G){ kload2(kf,kp0+sl_next,j); SBAR(); } }while(0)
  #define STEP(C0,C1,P0,P1,t,GK,GV,GL) do{ BIASC(C0,C1,t); SBAR(); \
    const lds_cptr vp_=vp0+sl_prev; \
    VRD(0); SBAR(); float sacc=(P0[0]+P0[1]); \
    GAPA(C0=__builtin_amdgcn_mfma_f32_32x32x16_bf16(kf[0],qr[0],C0,0,0,0), P0[2],P0[3],P0[4],P0[5],     pw0[0]=PKW(P0,0), pw0[1]=PKW(P0,2), pw0); \
    VRD(4); SBAR(); GAPA(C1=__builtin_amdgcn_mfma_f32_32x32x16_bf16(kf[1],qr[0],C1,0,0,0), P0[6],P0[7],P0[8],P0[9],     pw0[2]=PKW(P0,4), pw0[3]=PKW(P0,6), pw0); \
    VRD(1); SBAR(); GAPA(C0=__builtin_amdgcn_mfma_f32_32x32x16_bf16(kf[2],qr[1],C0,0,0,0),   P0[10],P0[11],P0[12],P0[13], pw1[0]=PKW(P0,8), pw1[1]=PKW(P0,10), pw1); \
    VRD(5); SBAR(); GAPA(C1=__builtin_amdgcn_mfma_f32_32x32x16_bf16(kf[3],qr[1],C1,0,0,0),   P0[14],P0[15],P1[0],P1[1],   pw1[2]=PKW(P0,12),pw1[3]=PKW(P0,14), pw1); \
    VRD(2); SBAR(); GAPA(C0=__builtin_amdgcn_mfma_f32_32x32x16_bf16(kf[4],qr[2],C0,0,0,0),   P1[2],P1[3],P1[4],P1[5],     pw2[0]=PKW(P1,0), pw2[1]=PKW(P1,2), pw2); \
    VRD(6); SBAR(); GAPA(C1=__builtin_amdgcn_mfma_f32_32x32x16_bf16(kf[5],qr[2],C1,0,0,0),   P1[6],P1[7],P1[8],P1[9],     pw2[2]=PKW(P1,4), pw2[3]=PKW(P1,6), pw2); \
    VRD(3); SBAR(); GAPA(C0=__builtin_amdgcn_mfma_f32_32x32x16_bf16(kf[6],qr[3],C0,0,0,0),   P1[10],P1[11],P1[12],P1[13], pw3[0]=PKW(P1,8), pw3[1]=PKW(P1,10), pw3); \
    VRD(7); SBAR(); GAPA(C1=__builtin_amdgcn_mfma_f32_32x32x16_bf16(kf[7],qr[3],C1,0,0,0),   P1[14],P1[15],0.f,0.f,       pw3[2]=PKW(P1,12),pw3[3]=PKW(P1,14), pw3); \
    l_reg+=sacc; \
    if(GK){DMA_K((t)+3,sl_cur);} if(GV){DMA_V((t)+1,sl_next);} \
    CMASK(C0,C1,t); \
    SBAR(); \
    GAPB(o[0]=__builtin_amdgcn_mfma_f32_32x32x16_bf16(PAF(0),VFR(0),o[0],0,0,0), C0,0); \
    GAPB(o[1]=__builtin_amdgcn_mfma_f32_32x32x16_bf16(PAF(0),VFR(4),o[1],0,0,0), C0,4); \
    KRD(GL,0); GAPB(o[0]=__builtin_amdgcn_mfma_f32_32x32x16_bf16(PAF(1),VFR(1),o[0],0,0,0), C0,8); \
    KRD(GL,1); GAPB(o[1]=__builtin_amdgcn_mfma_f32_32x32x16_bf16(PAF(1),VFR(5),o[1],0,0,0), C0,12); \
    KRD(GL,2); GAPB(o[0]=__builtin_amdgcn_mfma_f32_32x32x16_bf16(PAF(2),VFR(2),o[0],0,0,0), C1,0); \
    KRD(GL,3); GAPB(o[1]=__builtin_amdgcn_mfma_f32_32x32x16_bf16(PAF(2),VFR(6),o[1],0,0,0), C1,4); \
    GAPB(o[0]=__builtin_amdgcn_mfma_f32_32x32x16_bf16(PAF(3),VFR(3),o[0],0,0,0), C1,8); \
    GAPB(o[1]=__builtin_amdgcn_mfma_f32_32x32x16_bf16(PAF(3),VFR(7),o[1],0,0,0), C1,12); \
    }while(0)
  int t=1;
  #undef CMASK
  #define CMASK(P0,P1,t) do{}while(0)
  for(;t+5<NT;t+=2){
    STEP(pB0,pB1,pA0,pA1,t,true,true,true);     WAIT_BAR(2); RESC(); ROT();
    STEP(pA0,pA1,pB0,pB1,t+1,true,true,true);   WAIT_BAR(2); RESC(); ROT();
  }
  #undef CMASK
  #define CMASK(P0,P1,t) do{int jb_=(t)-(NT-4); if(jb_>=0)cmask(P0,P1,jb_,qrel,hi);}while(0)
  #define ENDW(tt) do{ if((tt)+3<NT){WAIT_BAR(2);} else if((tt)+2<NT){WAIT_BAR(1);} else {WAIT_BAR(0);} }while(0)
  for(;t+1<NT;t+=2){
    STEP(pB0,pB1,pA0,pA1,t,(t+3<NT),(t+1<NT),(t+1<NT));       ENDW(t);   RESC(); ROT();
    STEP(pA0,pA1,pB0,pB1,t+1,(t+4<NT),(t+2<NT),(t+2<NT));     ENDW(t+1); RESC(); ROT();
  }
  STEP(pB0,pB1,pA0,pA1,NT-1,false,false,false); RESC();
  { float sacc=pB0[0]+pB0[1]; _Pragma("unroll") for(int r=2;r<16;++r)sacc+=pB0[r]; _Pragma("unroll") for(int r=0;r<16;++r)sacc+=pB1[r]; l_reg+=sacc;
    pw0=(u32x4){PKW(pB0,0),PKW(pB0,2),PKW(pB0,4),PKW(pB0,6)};pw1=(u32x4){PKW(pB0,8),PKW(pB0,10),PKW(pB0,12),PKW(pB0,14)};pw2=(u32x4){PKW(pB1,0),PKW(pB1,2),PKW(pB1,4),PKW(pB1,6)};pw3=(u32x4){PKW(pB1,8),PKW(pB1,10),PKW(pB1,12),PKW(pB1,14)};
    SBAR(); pv(o,vb0+sl_cur,PAF(0),PAF(1),PAF(2),PAF(3)); }
  #undef PKW
  #undef PAF
  #undef VFR
  #undef PIN
  #undef MX3
  #undef GAPA
  #undef GAPB
  #undef EX
  #undef VRD
  #undef KRD
  #undef STEP
  #undef ENDW
  const bool lead_=(wid==0)&&(r32==0)&&(hi==0);
  unsigned nxt_=0; if(ctr!=nullptr&&lead_)nxt_=__hip_atomic_fetch_add(ctr,1u,__ATOMIC_RELAXED,__HIP_MEMORY_SCOPE_AGENT);
  {auto rr=__builtin_amdgcn_permlane32_swap(__float_as_uint(l_reg),__float_as_uint(l_reg),false,false);l_reg=__uint_as_float(rr[0])+__uint_as_float(rr[1]);}
  if(hi==0)wsf[32+r32]=l_reg;asm volatile("s_waitcnt lgkmcnt(0)":::"memory");
  float rli[16];
  #pragma unroll
  for(int r=0;r<16;++r)rli[r]=__builtin_amdgcn_rcpf(wsf[32+crow(r,hi)]);
  bf16*Ow=O+(rowbase+q0+wid*QBLK)*OPITCH+OCOL+h*D;
  { bf16*stg=(bf16*)(shm+LDS_OST)+wid*2048;
    #pragma unroll
    for(int r=0;r<16;++r){const int orow=crow(r,hi);
      #pragma unroll
      for(int d0=0;d0<2;++d0)stg[orow*64+d0*32+r32]=__float2bfloat16(o[d0][r]*rli[r]);}
    asm volatile("s_waitcnt lgkmcnt(0)":::"memory");
    #pragma unroll
    for(int i=0;i<4;++i){const int row=i*8+(lane>>3),ch=lane&7; const u32x4 v=*(const u32x4*)(stg+row*64+ch*8); ATTN_STORE16(Ow+(long)row*OPITCH+ch*8,v);} }
  if(ctr!=nullptr&&lead_)*(volatile __attribute__((address_space(3))) unsigned*)((__attribute__((address_space(3))) char*)shm+LDS_BYTES)=nxt_;
  asm volatile("s_waitcnt vmcnt(0) lgkmcnt(0)\n\ts_barrier":::"memory");
  #undef BIASC
  #undef DMA_K
  #undef DMA_V
  #undef CMASK
  #undef START
  #undef RESC
  #undef ROT
}
constexpr int ATTN_LDS_BYTES=LDS_BYTES;
struct AttnTensors { const bf16* Q; const bf16* K; const bf16* V; bf16* O; const float* FB; };
struct AttnUnit { int bh; int qb; };
struct StaticOrder {
  int vcu;
  __device__ __forceinline__ explicit StaticOrder(int grid,int block):vcu((block%8)*(grid/8)+block/8){}
  __device__ __forceinline__ bool next(int i,AttnUnit&u)const{ if(i>=4)return false; u.bh=vcu>>1; const int o=(vcu&1)*2; u.qb=(i==0)?o:(i==1)?7-o:(i==2)?o+1:6-o; return true; }
  __device__ __forceinline__ void a_ready(const AttnUnit&)const{}
  __device__ __forceinline__ void done(const AttnUnit&)const{}
};
template<class Sched,int THRL=8> __device__ __forceinline__ void attn_phase(char*lds,const AttnTensors&T,const Sched&S){
  AttnUnit u;
  for(int i=0;S.next(i,u);++i){ S.a_ready(u); attn_unit<THRL>(u.bh/NHEAD,u.bh%NHEAD,u.qb,T.Q,T.K,T.V,T.O,T.FB+(size_t)u.bh*SEQ,16.f,nullptr,lds); S.done(u); }
}
template<int THRL=8> __device__ __forceinline__ void attn_phase_dyn(char*lds,const AttnTensors&T,unsigned*ctr,const float*qg,const float*kg){
  volatile __attribute__((address_space(3))) unsigned*bw=(volatile __attribute__((address_space(3))) unsigned*)((__attribute__((address_space(3))) char*)lds+LDS_BYTES);
  const int tid=threadIdx.x,lane=tid&63;
  if(tid==0)*bw=__hip_atomic_fetch_add(ctr,1u,__ATOMIC_RELAXED,__HIP_MEMORY_SCOPE_AGENT);
  __syncthreads();
  for(;;){
    const unsigned u=*bw;
    if(u>=(unsigned)(BATCH*NHEAD*NQB))break;
    const int bh=u&(BATCH*NHEAD-1),qb=NQB-1-(int)(u>>7),h=bh%NHEAD;
    float gq=fabsf(qg[h*D+lane]),gk=fabsf(kg[h*D+lane]);
    #pragma unroll
    for(int o=1;o<64;o<<=1){gq=fmaxf(gq,__shfl_xor(gq,o));gk=fmaxf(gk,__shfl_xor(gk,o));}
    const float thr=__int_as_float(__builtin_amdgcn_readfirstlane(__float_as_int(1.02f*64.f*C2*gq*gk)));
    attn_unit<THRL>(bh/NHEAD,h,qb,T.Q,T.K,T.V,T.O,T.FB+(size_t)bh*SEQ,thr,ctr,lds);
  }
  __syncthreads();
}
#undef SBAR
#undef WAIT_BAR
}
#define GAS __attribute__((address_space(1)))
#define LAS __attribute__((address_space(3)))
typedef unsigned short bf16;
typedef unsigned v4u __attribute__((ext_vector_type(4)));
typedef float f32x4 __attribute__((ext_vector_type(4)));
typedef short bf16x8 __attribute__((ext_vector_type(8)));
typedef GAS unsigned gu32;
typedef GAS unsigned long long gu64;
#define RLX_AGENT __ATOMIC_RELAXED, __HIP_MEMORY_SCOPE_AGENT
#define LDS_WAIT() asm volatile("s_waitcnt lgkmcnt(0)" ::: "memory")
#define VM_WAIT() asm volatile("s_waitcnt vmcnt(0)" ::: "memory")
__device__ __forceinline__ unsigned long long rt() { return __builtin_amdgcn_s_memrealtime(); }
__device__ __forceinline__ unsigned f2bf(float f) { unsigned u = __builtin_bit_cast(unsigned, f); return (u + 0x7fffu + ((u >> 16) & 1u)) >> 16; }
__device__ __forceinline__ unsigned pk2(float lo, float hi) { return f2bf(lo) | (f2bf(hi) << 16); }

#define XB_TMO      128
#define XB_XCNT(j)  (256  + 64 * (j))
#define XB_XSUB(j)  (1280 + 64 * (j))
#define XB_XGEN(j)  (2304 + 64 * (j))
#define XB_TOP      3328
#define XB_TOPGEN   3392
#define XCD_BAR_WORDS 3456
#define XB_SPIN_CAP (1u << 18)

__device__ __forceinline__ unsigned xb_ld(unsigned* p)              { return __hip_atomic_load(p, __ATOMIC_RELAXED, __HIP_MEMORY_SCOPE_AGENT); }
__device__ __forceinline__ unsigned xb_add(unsigned* p, unsigned v) { return __hip_atomic_fetch_add(p, v, __ATOMIC_RELAXED, __HIP_MEMORY_SCOPE_AGENT); }
__device__ __forceinline__ unsigned xb_xcc_id() { return (unsigned)__builtin_amdgcn_s_getreg((3 << 11) | 20) & 0xFu; }
#define XB_SPIN(cond, bar) do { unsigned _sp = 0; while (cond) { __builtin_amdgcn_s_sleep(1); \
    if ((++_sp & 255u) == 0u) { if (xb_ld(&(bar)[XB_TMO])) break; if (_sp > XB_SPIN_CAP) { atomicAdd(&(bar)[XB_TMO], 1u); break; } } } } while (0)

struct XcdBarrier {
    unsigned* bar; unsigned x;
    volatile LAS unsigned* st;
};

__device__ __forceinline__ XcdBarrier xcd_barrier_post(unsigned* bar, volatile LAS unsigned* st) {
    XcdBarrier b; b.bar = bar; b.x = xb_xcc_id(); b.st = st;
    if (threadIdx.x == 0) (void)xb_add(&bar[XB_XCNT(b.x)], 1u);
    return b;
}
__device__ __forceinline__ void xcd_barrier_complete(unsigned* bar, unsigned x, unsigned& nloc, unsigned& nx) {
    const unsigned G = gridDim.x * gridDim.y * gridDim.z;
    unsigned sum, cnt, mine, sp = 0u;
    for (;;) {
        sum = 0u; cnt = 0u; mine = 0u;
#pragma unroll
        for (unsigned j = 0; j < 16; ++j) { const unsigned c = xb_ld(&bar[XB_XCNT(j)]); sum += c; cnt += (c > 0u) ? 1u : 0u; mine = (j == x) ? c : mine; }
        if (sum == G) break;
        __builtin_amdgcn_s_sleep(1);
        if ((++sp & 255u) == 0u) { if (xb_ld(&bar[XB_TMO])) break; if (sp > XB_SPIN_CAP) { atomicAdd(&bar[XB_TMO], 1u); break; } }
    }
    nloc = mine > 0u ? mine : 1u; nx = cnt > 0u ? cnt : 1u;
}

__device__ __forceinline__ void xcd_barrier(const XcdBarrier& b) {
    asm volatile("s_waitcnt vmcnt(0)" ::: "memory");
    __syncthreads();
    if (threadIdx.x == 0) {
        unsigned* bar = b.bar;
        __builtin_amdgcn_s_waitcnt(0);
        unsigned nloc = b.st[0], nx = b.st[1];
        if (nloc == 0u) { xcd_barrier_complete(bar, b.x, nloc, nx); b.st[0] = nloc; b.st[1] = nx; }
        const unsigned old = xb_add(&bar[XB_XSUB(b.x)], 1u);
        const unsigned gen = old / nloc;
        if (old + 1u == (gen + 1u) * nloc) {
            __builtin_amdgcn_fence(__ATOMIC_RELEASE, "agent");
            asm volatile("s_waitcnt vmcnt(0)" ::: "memory");
            const unsigned og = xb_add(&bar[XB_TOP], 1u);
            const unsigned tg = og / nx;
            if (og + 1u == (tg + 1u) * nx) xb_add(&bar[XB_TOPGEN], 1u);
            else XB_SPIN(xb_ld(&bar[XB_TOPGEN]) == tg, bar);
            __builtin_amdgcn_fence(__ATOMIC_ACQUIRE, "agent");
            xb_add(&bar[XB_XGEN(b.x)], 1u);
            asm volatile("s_waitcnt vmcnt(0)" ::: "memory");
        } else {
            XB_SPIN(xb_ld(&bar[XB_XGEN(b.x)]) == gen, bar);
            __builtin_amdgcn_fence(__ATOMIC_ACQUIRE, "agent");
            asm volatile("s_waitcnt vmcnt(0)" ::: "memory");
        }
    }
    __syncthreads();
}

constexpr int NWAVES = 8;
constexpr int D = 1024, BATCH = 16, SEQ = 2048, T = BATCH * SEQ, NH = 8, HD = 64, INW = 2056, QW = 512;
constexpr int NEXP = 16384;
constexpr float EPS = 1e-6f, LOG2E = 1.4426950408889634f, C2 = 0.125f * LOG2E;
constexpr size_t MiB = 1u << 20;
constexpr size_t WS_CTL = 0, CTL_ZERO_BYTES = 1 * MiB;
constexpr size_t WS_W1T = 1 * MiB, WS_WOT = 5 * MiB, WS_WST = 7 * MiB, WS_LFG = 13 * MiB, WS_FB = 14 * MiB, WS_RSQ = 15 * MiB, WS_RSTD = 17 * MiB, WS_R1 = 18 * MiB;
constexpr size_t WS_XN = 32 * MiB, WS_ZP = 96 * MiB, WS_Q = 128 * MiB, WS_K = 160 * MiB, WS_V = 192 * MiB, WS_YC = 224 * MiB;
constexpr size_t WS_SC = 32 * MiB;
constexpr size_t WS_X1B = 288 * MiB, WS_UF8 = 352 * MiB, WS_VF8 = 368 * MiB, WS_SU = 384 * MiB, WS_SV = 385 * MiB, WS_IDX = 416 * MiB, WS_GATE = 424 * MiB, WS_END = 440 * MiB;
constexpr size_t WS_PA = 32 * MiB, WS_COEF = 160 * MiB;
constexpr int CW_BAR = 4096;
constexpr int RING_BYTES = 131072, LDSCTL_OFF = RING_BYTES, MISC_OFF = LDSCTL_OFF + 320, LDS_BYTES = 147456;

__device__ __forceinline__ float wave_sum(float v) {
#pragma unroll
    for (int o = 1; o < 64; o <<= 1) v += __shfl_xor(v, o);
    return v;
}
__device__ __forceinline__ float bf2f(unsigned short b) { return __uint_as_float((unsigned)b << 16); }
__device__ __forceinline__ float bflo(unsigned u) { return __uint_as_float(u << 16); }
__device__ __forceinline__ float bfhi(unsigned u) { return __uint_as_float(u & 0xffff0000u); }

namespace pg8 {
struct EpiQKV {
    static constexpr bool PERM = true, AFTER_DRAIN = false;
    bf16_t* O; const float* qg; const float* kg; const float* r1;
    __device__ __forceinline__ void operator()(const f32x4 (&acc)[2][2][4][2], const Unit& u, int wr, int wc, int fr, int fq) const {
        const int kind = u.pn >> 1; const bool norm = (kind == 1) || (kind == 2);
        bf16_t* base = O + (size_t)kind * ((size_t)T * QW) + (u.pn & 1) * 256 + 64 * wc + 8 * fq;
        const int row0 = u.pm * BM + wr * 64 + fr;
        f32x4 g[2][2]; float sc = (kind == 1) ? C2 : 1.f;
#pragma unroll
        for (int bj = 0; bj < 2; ++bj)
#pragma unroll
            for (int n = 0; n < 2; ++n) g[bj][n] = (f32x4){1.f, 1.f, 1.f, 1.f};
        if (norm) { const float* gp = (kind == 1 ? qg : kg) + ((u.pn & 1) * 4 + wc) * 64 + 8 * fq;
#pragma unroll
            for (int bj = 0; bj < 2; ++bj)
#pragma unroll
                for (int n = 0; n < 2; ++n) g[bj][n] = *(const f32x4*)(gp + 32 * bj + 4 * n); }
#pragma unroll
        for (int ai = 0; ai < 2; ++ai)
#pragma unroll
            for (int m = 0; m < 4; ++m) {
                bf16_t* rowp = base + (size_t)(row0 + ai * HALF + m * 16) * QW;
                const float rr = r1[row0 + ai * HALF + m * 16]; float r = rr;
                if (norm) { float ss = 0.f;
#pragma unroll
                    for (int bj = 0; bj < 2; ++bj)
#pragma unroll
                        for (int n = 0; n < 2; ++n) { const f32x4 v = acc[ai][bj][m][n]; ss += (v[0] * v[0] + v[1] * v[1]) + (v[2] * v[2] + v[3] * v[3]); }
                    ss += __shfl_xor(ss, 16); ss += __shfl_xor(ss, 32);
                    r = rsqrtf(ss * (rr * rr) * (1.f / 64.f) + EPS) * sc * rr; }
#pragma unroll
                for (int bj = 0; bj < 2; ++bj) { const f32x4 v0 = acc[ai][bj][m][0] * g[bj][0] * r, v1 = acc[ai][bj][m][1] * g[bj][1] * r;
                    u32x4 w; w.x = cvt_pk_bf16(v0[0], v0[1]); w.y = cvt_pk_bf16(v0[2], v0[3]); w.z = cvt_pk_bf16(v1[0], v1[1]); w.w = cvt_pk_bf16(v1[2], v1[3]);
                    *(u32x4*)(rowp + 32 * bj) = w; }
            }
    }
};
struct EpiX1 {
    static constexpr bool PERM = false, AFTER_DRAIN = false;
    const bf16_t* xb; float* out; bf16_t* x1b; float* rsq;
    __device__ __forceinline__ void operator()(const f32x4 (&acc)[2][2][4][2], const Unit& u, int wr, int wc, int fr, int fq) const {
        typedef unsigned u32x2v __attribute__((ext_vector_type(2)));
        const int row0 = u.pm * BM + wr * 64 + fr, col0 = u.pn * BM + wc * 32 + 4 * fq;
#pragma unroll
        for (int ai = 0; ai < 2; ++ai) {
            u32x2v pre[4][2][2];
#pragma unroll
            for (int m = 0; m < 4; ++m) { const size_t ro = (size_t)(row0 + ai * HALF + m * 16) * D + col0;
#pragma unroll
                for (int bj = 0; bj < 2; ++bj)
#pragma unroll
                    for (int n = 0; n < 2; ++n) pre[m][bj][n] = *(const u32x2v*)(xb + ro + bj * HALF + n * 16); }
#pragma unroll
            for (int m = 0; m < 4; ++m) { const int row = row0 + ai * HALF + m * 16; const size_t ro = (size_t)row * D + col0; float ss = 0.f;
#pragma unroll
                for (int bj = 0; bj < 2; ++bj)
#pragma unroll
                    for (int n = 0; n < 2; ++n) { const size_t off = ro + bj * HALF + n * 16; const u32x2v pw = pre[m][bj][n]; const f32x4 v = acc[ai][bj][m][n] + (f32x4){__uint_as_float(pw.x << 16), __uint_as_float(pw.x & 0xffff0000u), __uint_as_float(pw.y << 16), __uint_as_float(pw.y & 0xffff0000u)};
                        ss += (v[0] * v[0] + v[1] * v[1]) + (v[2] * v[2] + v[3] * v[3]);
                        u32x2v w; w.x = cvt_pk_bf16(v[0], v[1]); w.y = cvt_pk_bf16(v[2], v[3]); *(u32x2v*)(x1b + off) = w; }
                ss += __shfl_xor(ss, 16); ss += __shfl_xor(ss, 32);
                if (fq == 0) rsq[(size_t)row * 16 + u.pn * 4 + wc] = ss; }
        }
    }
};
struct EpiSc {
    static constexpr bool PERM = true, AFTER_DRAIN = false;
    bf16_t* C;
    __device__ __forceinline__ void operator()(const f32x4 (&acc)[2][2][4][2], const Unit& u, int wr, int wc, int fr, int fq) const {
        const int row0 = u.pm * BM + wr * 64 + fr, col0 = u.pn * BM + wc * 32 + 8 * fq;
#pragma unroll
        for (int ai = 0; ai < 2; ++ai)
#pragma unroll
            for (int m = 0; m < 4; ++m) { bf16_t* rowp = C + (size_t)(row0 + ai * HALF + m * 16) * 2048 + col0;
#pragma unroll
                for (int bj = 0; bj < 2; ++bj) { const f32x4 v0 = acc[ai][bj][m][0], v1 = acc[ai][bj][m][1];
                    u32x4 w; w.x = cvt_pk_bf16(v0[0], v0[1]); w.y = cvt_pk_bf16(v0[2], v0[3]); w.z = cvt_pk_bf16(v1[0], v1[1]); w.w = cvt_pk_bf16(v1[2], v1[3]);
                    *(u32x4*)(rowp + bj * HALF) = w; } }
    }
};
}

__device__ __forceinline__ void p0_transpose_item(const float* W, int ldw, int col0, bf16* WT, int dst0, float* scr, int kb, int lane, const float* kgain) {
    const int k0 = 64 * kb;
#pragma unroll 8
    for (int i = 0; i < 32; ++i) { const int kk = 2 * i + (lane >> 5); scr[kk * 33 + (lane & 31)] = W[(size_t)(k0 + kk) * ldw + col0 + (lane & 31)] * (kgain ? kgain[k0 + kk] : 1.f); }
    LDS_WAIT(); asm volatile("" ::: "memory");
    const int c = lane & 7;
#pragma unroll
    for (int j = 0; j < 4; ++j) { const int n = (lane >> 3) + 8 * j; const float* s = scr + (8 * c) * 33 + n;
        v4u o; o.x = pk2(s[0 * 33], s[1 * 33]); o.y = pk2(s[2 * 33], s[3 * 33]); o.z = pk2(s[4 * 33], s[5 * 33]); o.w = pk2(s[6 * 33], s[7 * 33]);
        *(v4u*)(WT + (size_t)(dst0 + n) * 1024 + k0 + 8 * c) = o; }
    LDS_WAIT(); asm volatile("" ::: "memory");
}
__device__ __forceinline__ int w1_dst_row(int n) { const int w = n & 255; return (n & ~255) + 128 * ((w >> 5) & 1) + 32 * (w >> 6) + (w & 31); }

struct Args { const float* in[14]; float* out; unsigned char* ws; };

__device__ __forceinline__ void p3_wsfold(const Args& a, unsigned char* lds, int vcu, int wave, int tid) {
    const float* n2g = a.in[9]; const float* w_query = a.in[10]; const float* sk = a.in[11]; bf16* WST = (bf16*)(a.ws + WS_WST);
    {
        const int grp = vcu >> 4, kb = vcu & 15, h = grp >> 1, half = grp & 1, k0 = kb * 64;
        float* skT = (float*)lds;
        float* wqt = (float*)(lds + 67584);
        for (int i = tid; i < 128 * 128; i += NWAVES * 64) skT[(i & 127) * 132 + (i >> 7)] = sk[(size_t)half * 16384 + i];
        for (int i = tid; i < 64 * 128; i += NWAVES * 64) { const int r = i >> 7, c = i & 127; wqt[r * 129 + c] = w_query[(size_t)(k0 + r) * 2048 + h * 256 + half * 128 + c] * n2g[k0 + r]; }
        __syncthreads();
        const int kq = tid & 63; float acc[16];
#pragma unroll
        for (int q = 0; q < 16; ++q) acc[q] = 0.f;
#pragma unroll 4
        for (int c = 0; c < 128; ++c) { const float w = wqt[kq * 129 + c];
#pragma unroll
            for (int q = 0; q < 4; ++q) { const f32x4 s4 = *(const f32x4*)(skT + c * 132 + wave * 16 + 4 * q); acc[4 * q] += w * s4.x; acc[4 * q + 1] += w * s4.y; acc[4 * q + 2] += w * s4.z; acc[4 * q + 3] += w * s4.w; } }
#pragma unroll
        for (int q = 0; q < 16; ++q) WST[(size_t)(grp * 128 + wave * 16 + q) * 1024 + k0 + kq] = (bf16)f2bf(acc[q]);
        __syncthreads();
    }
}
__device__ __forceinline__ void p0_prologue(const Args& a, unsigned char* lds, int vcu, int G, int wave, int lane, int tid, int mask) {
    const float* w_in = a.in[2]; const float* w_pool = a.in[6]; const float* pscale = a.in[7]; const float* w_out = a.in[8]; const float* n2g = a.in[9];
    const float* w_query = a.in[10]; const float* sk = a.in[11];
    bf16* W1T = (bf16*)(a.ws + WS_W1T); bf16* WOT = (bf16*)(a.ws + WS_WOT); bf16* WST = (bf16*)(a.ws + WS_WST);
    const int NGW = G * NWAVES;
    const int gwi = wave * G + vcu;
    { float* wf = (float*)lds;
      for (int i = tid; i < 1024 * 8; i += NWAVES * 64) wf[(i & 7) * 1024 + (i >> 3)] = w_in[(size_t)(i >> 3) * INW + 2048 + (i & 7)]; }
    __syncthreads();
    float* scr = (float*)(lds + 32768 + wave * 8704);
    if (mask & 1) {
    for (int it = (gwi + 2 * G) % NGW; it < 768 + 512; it += NGW) {
        if (it < 768) { const int nb = it >> 4, kb = it & 15, n0 = 512 + 32 * nb; p0_transpose_item(w_in, INW, n0, W1T, w1_dst_row(n0), scr, kb, lane, a.in[1]); }
        else { const int r = it - 768, nb = r >> 4, kb = r & 15; p0_transpose_item(w_out, D, 32 * nb, WOT, 32 * nb, scr, kb, lane, nullptr); }
    }
    typedef const __attribute__((address_space(4))) float* cfp;
    for (int it = (gwi + 6 * G) % NGW; it < 1024; it += NGW) {
        const int kb = __builtin_amdgcn_readfirstlane(it >> 3), g = __builtin_amdgcn_readfirstlane((it >> 1) & 3), d = (it & 1) * 64 + lane, k0 = 8 * kb; float acc[8];
#pragma unroll
        for (int q = 0; q < 8; ++q) acc[q] = 0.f;
#pragma unroll 1
        for (int c0 = 0; c0 < 128; c0 += 8) { float wp[8];
#pragma unroll
            for (int c = 0; c < 8; ++c) wp[c] = w_pool[((size_t)g * 128 + c0 + c) * 128 + d];
#pragma unroll
            for (int q = 0; q < 8; ++q) { cfp wr = (cfp)(w_in + (size_t)(k0 + q) * INW + g * 128 + c0);
#pragma unroll
                for (int c = 0; c < 8; ++c) acc[q] += wr[c] * wp[c]; } }
        const float s = pscale[g * 128 + d]; { const float* g1k = a.in[1] + k0;
#pragma unroll
            for (int q = 0; q < 8; ++q) acc[q] *= s * g1k[q]; }
        v4u o; o.x = pk2(acc[0], acc[1]); o.y = pk2(acc[2], acc[3]); o.z = pk2(acc[4], acc[5]); o.w = pk2(acc[6], acc[7]);
        *(v4u*)(W1T + (size_t)w1_dst_row(g * 128 + d) * 1024 + k0) = o;
    }
    }
    if (mask & 4) { const float* wf = (const float*)lds;
      const float* x = a.in[0]; const float* g1 = a.in[1]; const float* bfg = a.in[3]; bf16* XN = (bf16*)(a.ws + WS_XN); float* LFG = (float*)(a.ws + WS_LFG);
      const int per = T / G;
      for (int q = 2 * wave; q < per; q += 2 * NWAVES) {
          f32x4 v[2][4];
#pragma unroll
          for (int u = 0; u < 2; ++u) { const f32x4* xr = (const f32x4*)(x + (size_t)(vcu * per + q + u) * D) + lane;
#pragma unroll
              for (int j = 0; j < 4; ++j) v[u][j] = __builtin_nontemporal_load(xr + 64 * j); }
#pragma unroll
          for (int u = 0; u < 2; ++u) { const int m = vcu * per + q + u; float s = 0.f;
#pragma unroll
              for (int j = 0; j < 4; ++j) s += (v[u][j].x * v[u][j].x + v[u][j].y * v[u][j].y) + (v[u][j].z * v[u][j].z + v[u][j].w * v[u][j].w);
              const float r = rsqrtf(wave_sum(s) * (1.f / D) + EPS); float f[8]; if (lane == 0) ((float*)(a.ws + WS_R1))[m] = r;
#pragma unroll
              for (int h = 0; h < 8; ++h) f[h] = 0.f;
              unsigned long long* o8 = (unsigned long long*)(XN + (size_t)m * D) + lane;
#pragma unroll
              for (int j = 0; j < 4; ++j) { const f32x4 gg = ((const f32x4*)g1)[lane + 64 * j]; const f32x4 hv = v[u][j] * r * gg;
                  o8[64 * j] = (unsigned long long)pk2(v[u][j].x, v[u][j].y) | ((unsigned long long)pk2(v[u][j].z, v[u][j].w) << 32);
#pragma unroll
                  for (int h = 0; h < 8; ++h) { const f32x4 w4 = *(const f32x4*)(wf + h * 1024 + 4 * (lane + 64 * j)); f[h] += (hv.x * w4.x + hv.y * w4.y) + (hv.z * w4.z + hv.w * w4.w); } }
#pragma unroll
              for (int h = 0; h < 8; ++h) f[h] = wave_sum(f[h]);
              float fs = f[0];
#pragma unroll
              for (int h = 1; h < 8; ++h) fs = (lane == h) ? f[h] : fs;
              if (lane < 8) { const float z = fs + bfg[lane]; LFG[(size_t)m * 8 + lane] = fminf(z, 0.f) - log1pf(expf(-fabsf(z))); } } }
    }
}

__device__ __forceinline__ void p1_cumsum(const Args& a, unsigned char* lds, int wave, int lane, int tid) {
    if (blockIdx.x < BATCH * NH) {
        const int bh = blockIdx.x, b = bh >> 3, h = bh & 7; const float* LFG = (const float*)(a.ws + WS_LFG); float* FB = (float*)(a.ws + WS_FB);
        float v[4];
#pragma unroll
        for (int i = 0; i < 4; ++i) v[i] = LFG[((size_t)b * SEQ + tid * 4 + i) * 8 + h];
        v[1] += v[0]; v[2] += v[1]; v[3] += v[2];
        const float tot = v[3]; float sc = tot;
#pragma unroll
        for (int o = 1; o < 64; o <<= 1) { const float n = __shfl_up(sc, o); if (lane >= o) sc += n; }
        float* wt = (float*)lds; if (lane == 63) wt[wave] = sc; __syncthreads();
        float off = 0.f; for (int w = 0; w < wave; ++w) off += wt[w];
        const float excl = off + sc - tot;
#pragma unroll
        for (int i = 0; i < 4; ++i) FB[(size_t)bh * SEQ + tid * 4 + i] = -(excl + v[i]) * LOG2E;
        __syncthreads();
    }
}

__device__ __forceinline__ void p2_pool(const Args& a, int gtid, int NGT) {
    const bf16* ZP = (const bf16*)(a.ws + WS_ZP); bf16* YC = (bf16*)(a.ws + WS_YC);
    for (int it = gtid; it < T * 64; it += NGT) {
        const int t = it >> 6, c8 = (it & 63) * 8, s = t & (SEQ - 1), w = 2 << (c8 >> 7); const int start = s + 1 - w > 0 ? s + 1 - w : 0;
        float acc[8];
#pragma unroll
        for (int i = 0; i < 8; ++i) acc[i] = 0.f;
        v4u cur = (v4u){0u, 0u, 0u, 0u};
        for (int jj = start; jj <= s; ++jj) { cur = *(const v4u*)(ZP + (size_t)(t - s + jj) * QW + c8);
            acc[0] += bflo(cur.x); acc[1] += bfhi(cur.x); acc[2] += bflo(cur.y); acc[3] += bfhi(cur.y); acc[4] += bflo(cur.z); acc[5] += bfhi(cur.z); acc[6] += bflo(cur.w); acc[7] += bfhi(cur.w); }
        const float ic = 1.f / (float)(s + 1 - start);
        v4u o; o.x = pk2(acc[0] * ic - bflo(cur.x), acc[1] * ic - bfhi(cur.x)); o.y = pk2(acc[2] * ic - bflo(cur.y), acc[3] * ic - bfhi(cur.y));
        o.z = pk2(acc[4] * ic - bflo(cur.z), acc[5] * ic - bfhi(cur.z)); o.w = pk2(acc[6] * ic - bflo(cur.w), acc[7] * ic - bfhi(cur.w));
        *(v4u*)(YC + (size_t)t * D + c8) = o;
    }
}

__device__ __forceinline__ float kmax(float a, float b) { float r; asm("v_max_f32_e32 %0, %1, %2" : "=v"(r) : "v"(a), "v"(b)); return r; }
__device__ __forceinline__ float kmin(float a, float b) { float r; asm("v_min_f32_e32 %0, %1, %2" : "=v"(r) : "v"(a), "v"(b)); return r; }
#define RT_CE(a, b) do { const float h_ = kmax(a, b), l_ = kmin(a, b); a = h_; b = l_; } while (0)
template <int N> __device__ __forceinline__ void rt_sort_desc(float (&x)[N]) {
#pragma unroll
    for (int k = 2; k <= N; k <<= 1)
#pragma unroll
        for (int j = k >> 1; j > 0; j >>= 1)
#pragma unroll
            for (int i = 0; i < N; ++i) { const int l = i ^ j; if (l > i) { if ((i & k) == 0) RT_CE(x[i], x[l]); else RT_CE(x[l], x[i]); } }
}
__device__ __forceinline__ void rt_merge16(float (&A)[16], const float (&B)[16]) {
#pragma unroll
    for (int i = 0; i < 16; ++i) A[i] = kmax(A[i], B[15 - i]);
#pragma unroll
    for (int j = 8; j > 0; j >>= 1)
#pragma unroll
        for (int i = 0; i < 16; ++i) { const int l = i ^ j; if (l > i) RT_CE(A[i], A[l]); }
}
__device__ __forceinline__ float rt_key(float v, unsigned mask, unsigned code) { return __uint_as_float((__float_as_uint(v) & mask) | code); }

__device__ __forceinline__ unsigned q8_pack4(float x0, float x1, float x2, float x3, float inv) {
    const unsigned y0 = __builtin_bit_cast(unsigned, __builtin_fmaf(x0, inv, 12582912.f)), y1 = __builtin_bit_cast(unsigned, __builtin_fmaf(x1, inv, 12582912.f));
    const unsigned y2 = __builtin_bit_cast(unsigned, __builtin_fmaf(x2, inv, 12582912.f)), y3 = __builtin_bit_cast(unsigned, __builtin_fmaf(x3, inv, 12582912.f));
    return (y0 & 0xffu) | ((y1 & 0xffu) << 8) | ((y2 & 0xffu) << 16) | (y3 << 24);
}
__device__ __forceinline__ void tbl_load(const Args& a, int r, int lane, f32x4 (&v)[4]) {
    const bool isv = r >= NEXP; const int e = isv ? r - NEXP : r; const float* src = (isv ? a.in[13] : a.in[12]) + (size_t)e * D + 16 * lane;
#pragma unroll
    for (int j = 0; j < 4; ++j) v[j] = __builtin_nontemporal_load((const f32x4*)(src + 4 * j));
}
__device__ __forceinline__ void tbl_store(const Args& a, int r, int lane, f32x4 (&v)[4]) {
    const bool isv = r >= NEXP; const int e = isv ? r - NEXP : r; const float* n2g = a.in[9]; float am = 0.f;
#pragma unroll
    for (int j = 0; j < 4; ++j) { if (!isv) v[j] = v[j] * *(const f32x4*)(n2g + 16 * lane + 4 * j);
        am = fmaxf(am, fmaxf(fmaxf(fabsf(v[j].x), fabsf(v[j].y)), fmaxf(fabsf(v[j].z), fabsf(v[j].w)))); }
#pragma unroll
    for (int o = 1; o < 64; o <<= 1) am = fmaxf(am, __shfl_xor(am, o));
    const float sc = am > 0.f ? am * (isv ? 1.f / 448.f : 1.f / 127.f) : 1.f, inv = 1.f / sc; v4u o;
    if (isv) {
#pragma unroll
        for (int j = 0; j < 4; ++j) { int w = 0; w = __builtin_amdgcn_cvt_pk_fp8_f32(v[j].x * inv, v[j].y * inv, w, false); w = __builtin_amdgcn_cvt_pk_fp8_f32(v[j].z * inv, v[j].w * inv, w, true); o[j] = (unsigned)w; }
    } else {
#pragma unroll
        for (int j = 0; j < 4; ++j) o[j] = q8_pack4(v[j].x, v[j].y, v[j].z, v[j].w, inv);
    }
    *(v4u*)((isv ? a.ws + WS_VF8 : a.ws + WS_UF8) + (size_t)e * D + 16 * lane) = o;
    if (lane == 0) ((float*)(a.ws + WS_SU))[2 * e + (isv ? 1 : 0)] = sc;
}
__device__ __forceinline__ void p5_route(const Args& a, unsigned char* lds, int gw, int NGW, int wave, int lane) {
    const bf16* SC = (const bf16*)(a.ws + WS_SC); const float* RSQ = (const float*)(a.ws + WS_RSQ); float* RSTD = (float*)(a.ws + WS_RSTD);
    unsigned short* IDX = (unsigned short*)(a.ws + WS_IDX); float* GATE = (float*)(a.ws + WS_GATE);
    float* tile = (float*)(lds + wave * 12288);
    unsigned char* ibuf = lds + wave * 12288 + 8448 + lane * 32;
    int trow = gw * ((2 * NEXP) / NGW);
    const int trow_end = trow + (2 * NEXP) / NGW;
    for (int task = gw; task < (T / 64) * 8; task += NGW) {
        const int tb = task >> 3, h = task & 7, t0 = tb * 64, t = t0 + lane;
        float rs = 0.f;
        { const f32x4* rp = (const f32x4*)(RSQ + (size_t)t * 16);
#pragma unroll
          for (int i = 0; i < 4; ++i) { const f32x4 v = rp[i]; rs += (v.x + v.y) + (v.z + v.w); } }
        const float rstd = rsqrtf(rs * (1.f / D) + EPS);
        if (h == 0) RSTD[t] = rstd;
        float L1[16], L2[16];
#pragma unroll
        for (int half = 0; half < 2; ++half) {
            float L[16];
#pragma unroll
            for (int q = 0; q < 4; ++q) {
                f32x4 tv[4]; const bool tdo = trow < trow_end; if (tdo) tbl_load(a, trow, lane, tv);
                const bf16* src = SC + (size_t)t0 * 2048 + h * 256 + half * 128 + q * 32 + 8 * (lane & 3);
#pragma unroll
                for (int i = 0; i < 4; ++i) { const int row = (lane >> 2) + 16 * i; const v4u v = *(const v4u*)(src + (size_t)row * 2048);
                    float* d = tile + row * 33 + 8 * (lane & 3); d[0] = bflo(v.x); d[1] = bfhi(v.x); d[2] = bflo(v.y); d[3] = bfhi(v.y); d[4] = bflo(v.z); d[5] = bfhi(v.z); d[6] = bflo(v.w); d[7] = bfhi(v.w); }
                LDS_WAIT(); asm volatile("" ::: "memory");
                float x0[16], x1[16];
#pragma unroll
                for (int c = 0; c < 16; ++c) { x0[c] = rt_key(tile[lane * 33 + c], ~127u, (unsigned)(127 - (q * 32 + c))); x1[c] = rt_key(tile[lane * 33 + 16 + c], ~127u, (unsigned)(127 - (q * 32 + 16 + c))); }
                LDS_WAIT(); asm volatile("" ::: "memory");
                rt_sort_desc<16>(x0); rt_sort_desc<16>(x1); rt_merge16(x0, x1);
                if (q == 0) {
#pragma unroll
                    for (int c = 0; c < 16; ++c) L[c] = x0[c];
                } else rt_merge16(L, x0);
                if (tdo) { tbl_store(a, trow, lane, tv); ++trow; }
            }
#pragma unroll
            for (int c = 0; c < 16; ++c) { if (half == 0) L1[c] = L[c]; else L2[c] = L[c]; }
        }
        { unsigned w[8];
#pragma unroll
          for (int c = 0; c < 4; ++c) { w[c] = (__float_as_uint(L1[4 * c]) & 127u) | ((__float_as_uint(L1[4 * c + 1]) & 127u) << 8) | ((__float_as_uint(L1[4 * c + 2]) & 127u) << 16) | ((__float_as_uint(L1[4 * c + 3]) & 127u) << 24);
              w[4 + c] = (__float_as_uint(L2[4 * c]) & 127u) | ((__float_as_uint(L2[4 * c + 1]) & 127u) << 8) | ((__float_as_uint(L2[4 * c + 2]) & 127u) << 16) | ((__float_as_uint(L2[4 * c + 3]) & 127u) << 24); }
          *(v4u*)ibuf = (v4u){w[0] ^ 0x7f7f7f7fu, w[1] ^ 0x7f7f7f7fu, w[2] ^ 0x7f7f7f7fu, w[3] ^ 0x7f7f7f7fu}; *(v4u*)(ibuf + 16) = (v4u){w[4] ^ 0x7f7f7f7fu, w[5] ^ 0x7f7f7f7fu, w[6] ^ 0x7f7f7f7fu, w[7] ^ 0x7f7f7f7fu}; }
        float C[16];
#pragma unroll
        for (int b = 0; b < 16; ++b) C[b] = rt_key(L1[0] + L2[b], ~255u, (unsigned)(255 - b));
#pragma unroll
        for (int aa = 1; aa < 16; ++aa)
#pragma unroll
            for (int b = 0; b < 16; ++b) if ((aa + 1) * (b + 1) <= 16) {
                float x = rt_key(L1[aa] + L2[b], ~255u, (unsigned)(255 - (16 * aa + b)));
#pragma unroll
                for (int i = (aa + 1) * (b + 1) - 1; i < 16; ++i) RT_CE(C[i], x);
            }
        LDS_WAIT(); asm volatile("" ::: "memory");
        float g[16], sum = 0.f; unsigned ex[16];
#pragma unroll
        for (int i = 0; i < 16; ++i) { const unsigned code = 255u - (__float_as_uint(C[i]) & 255u); ex[i] = (unsigned)ibuf[code >> 4] * 128u + (unsigned)ibuf[16 + (code & 15u)];
            g[i] = __builtin_amdgcn_exp2f((C[i] - C[0]) * (rstd * LOG2E)); sum += g[i]; }
        const float inv = 1.f / sum;
        unsigned short* ip = IDX + (size_t)t * 128 + h * 16; float* gp = GATE + (size_t)t * 128 + h * 16;
        *(v4u*)ip = (v4u){ex[0] | (ex[1] << 16), ex[2] | (ex[3] << 16), ex[4] | (ex[5] << 16), ex[6] | (ex[7] << 16)};
        *(v4u*)(ip + 8) = (v4u){ex[8] | (ex[9] << 16), ex[10] | (ex[11] << 16), ex[12] | (ex[13] << 16), ex[14] | (ex[15] << 16)};
#pragma unroll
        for (int i = 0; i < 4; ++i) *(f32x4*)(gp + 4 * i) = (f32x4){g[4 * i] * inv, g[4 * i + 1] * inv, g[4 * i + 2] * inv, g[4 * i + 3] * inv};
        LDS_WAIT(); asm volatile("" ::: "memory");
    }
    for (; trow < trow_end; ++trow) { f32x4 tv[4]; tbl_load(a, trow, lane, tv); tbl_store(a, trow, lane, tv); }
}

typedef float f32x2 __attribute__((ext_vector_type(2)));
__device__ __forceinline__ float dpp_sum8(float s) {
    s += __builtin_bit_cast(float, __builtin_amdgcn_update_dpp(0, __builtin_bit_cast(int, s), 0xB1, 0xF, 0xF, true));
    s += __builtin_bit_cast(float, __builtin_amdgcn_update_dpp(0, __builtin_bit_cast(int, s), 0x4E, 0xF, 0xF, true));
    s += __builtin_bit_cast(float, __builtin_amdgcn_update_dpp(0, __builtin_bit_cast(int, s), 0x141, 0xF, 0xF, true));
    return s;
}
typedef __bf16 bf16x2_t __attribute__((ext_vector_type(2)));
typedef _Float16 f16x2_t __attribute__((ext_vector_type(2)));
#ifdef PROBE_U2
#define EX_REPU _Pragma("unroll 1") for (int ru_ = 0; ru_ < 2; ++ru_)
#else
#define EX_REPU
#endif
#ifdef PROBE_V2
#define EX_REPV _Pragma("unroll 1") for (int rv_ = 0; rv_ < 2; ++rv_)
#else
#define EX_REPV
#endif
#define EX_IDX(iw, i) (((i) & 1) ? ((iw)[(i) >> 1] >> 16) : ((iw)[(i) >> 1] & 0xffffu))
#define EX_GATHER(r, iw, tbase, loff) do { _Pragma("unroll") for (int i_ = 0; i_ < 8; ++i_) r[i_] = *(const v4u*)((tbase) + (unsigned)((EX_IDX(iw, i_) << 10) + (loff))); } while (0)
__device__ __forceinline__ void p6_experts(const Args& a, unsigned char* lds, int bx, int vcu, int wave, int lane, int tid) {
    const bf16* X1B = (const bf16*)(a.ws + WS_X1B); const unsigned char* UF8 = a.ws + WS_UF8; const unsigned char* VF8 = a.ws + WS_VF8;
    const unsigned short* IDX = (const unsigned short*)(a.ws + WS_IDX); const float* GATE = (const float*)(a.ws + WS_GATE);
    const float* RSTD = (const float*)(a.ws + WS_RSTD); const f32x2* SUV = (const f32x2*)(a.ws + WS_SU);
    float* dots = (float*)lds;
    unsigned* idl = (unsigned*)(lds + 65536);
    const int xg = bx & 7, t0 = vcu * 128, l8 = lane & 7;
#pragma unroll
    for (int k = 0; k < 2; ++k) { const int tl = wave * 8 + (lane >> 3) + 64 * k; const v4u* src = (const v4u*)(IDX + (size_t)(t0 + tl) * 128); v4u* dst = (v4u*)(idl + tl * 128); v4u* dz = (v4u*)(dots + tl * 128);
#pragma unroll
        for (int h = 0; h < 2; ++h) { const v4u w = src[8 * h + l8];
            const unsigned w0 = w.x, w1 = w.y, w2 = w.z, w3 = w.w;
            dst[2 * (8 * h + l8)]     = (v4u){(w0 & 0xffffu) << 10, (w0 >> 16) << 10, (w1 & 0xffffu) << 10, (w1 >> 16) << 10};
            dst[2 * (8 * h + l8) + 1] = (v4u){(w2 & 0xffffu) << 10, (w2 >> 16) << 10, (w3 & 0xffffu) << 10, (w3 >> 16) << 10}; }
#pragma unroll
        for (int h = 0; h < 4; ++h) dz[8 * h + l8] = (v4u){0u, 0u, 0u, 0u}; }
    LDS_WAIT(); asm volatile("" ::: "memory");
#define EX_IDS(dst, p) do { dst[0] = *(const v4u*)(p); dst[1] = *(const v4u*)((p) + 4); } while (0)
#define EX_GATHER2(r, iw, tbase, loff) do { _Pragma("unroll") for (int i_ = 0; i_ < 8; ++i_) r[i_] = *(const v4u*)((tbase) + (unsigned)(iw[i_ >> 2][i_ & 3] + (loff))); } while (0)
    EX_REPU {
        int tl = wave * 8 + (lane >> 3);
        unsigned ub = 128u * (unsigned)(xg & 7) + 16u * (unsigned)l8;
        const unsigned* ip = idl + tl * 128;
        int x[4], xn[4]; float xs = 0.f, xsn = 0.f;
#define UD_LOADX(xv, xsv, tl_, j_) do { const bf16* xp_ = X1B + (size_t)(t0 + (tl_)) * D + 128 * (j_) + 16 * l8; const v4u w0_ = *(const v4u*)xp_, w1_ = *(const v4u*)(xp_ + 8); \
            const unsigned s0_ = w0_.x, s1_ = w0_.y, s2_ = w0_.z, s3_ = w0_.w, s4_ = w1_.x, s5_ = w1_.y, s6_ = w1_.z, s7_ = w1_.w; \
            float am_ = fmaxf(fmaxf(fmaxf(fabsf(bflo(s0_)), fabsf(bfhi(s0_))), fmaxf(fabsf(bflo(s1_)), fabsf(bfhi(s1_)))), fmaxf(fmaxf(fabsf(bflo(s2_)), fabsf(bfhi(s2_))), fmaxf(fabsf(bflo(s3_)), fabsf(bfhi(s3_))))); \
            am_ = fmaxf(am_, fmaxf(fmaxf(fmaxf(fabsf(bflo(s4_)), fabsf(bfhi(s4_))), fmaxf(fabsf(bflo(s5_)), fabsf(bfhi(s5_)))), fmaxf(fmaxf(fabsf(bflo(s6_)), fabsf(bfhi(s6_))), fmaxf(fabsf(bflo(s7_)), fabsf(bfhi(s7_)))))); \
            am_ = fmaxf(am_, __builtin_bit_cast(float, __builtin_amdgcn_update_dpp(0, __builtin_bit_cast(int, am_), 0xB1, 0xF, 0xF, true))); \
            am_ = fmaxf(am_, __builtin_bit_cast(float, __builtin_amdgcn_update_dpp(0, __builtin_bit_cast(int, am_), 0x4E, 0xF, 0xF, true))); \
            am_ = fmaxf(am_, __builtin_bit_cast(float, __builtin_amdgcn_update_dpp(0, __builtin_bit_cast(int, am_), 0x141, 0xF, 0xF, true))); \
            am_ = fmaxf(am_, 1e-20f); const float qi_ = 127.f / am_; xsv = am_ * (1.f / 127.f); \
            xv[0] = (int)q8_pack4(bflo(s0_), bfhi(s0_), bflo(s1_), bfhi(s1_), qi_); xv[1] = (int)q8_pack4(bflo(s2_), bfhi(s2_), bflo(s3_), bfhi(s3_), qi_); \
            xv[2] = (int)q8_pack4(bflo(s4_), bfhi(s4_), bflo(s5_), bfhi(s5_), qi_); xv[3] = (int)q8_pack4(bflo(s6_), bfhi(s6_), bflo(s7_), bfhi(s7_), qi_); } while (0)
#define UD_CONSUME(r, pbase) do { int res_[8]; const float old_ = pa[(pbase) + l8];     \
            _Pragma("unroll") for (int i_ = 0; i_ < 8; ++i_) { int acc_ = 0; \
            _Pragma("unroll") for (int c_ = 0; c_ < 4; ++c_) acc_ = __builtin_amdgcn_sdot4((int)r[i_][c_], x[c_], acc_, false); \
            res_[i_] = acc_; } \
              \
            int va_[4], vb_[2]; \
            _Pragma("unroll") for (int k_ = 0; k_ < 4; ++k_) { const int kp_ = hb4_ ? res_[k_ + 4] : res_[k_], sd_ = hb4_ ? res_[k_] : res_[k_ + 4]; va_[k_] = kp_ + __builtin_amdgcn_update_dpp(0, sd_, 0x141, 0xF, 0xF, true); } \
            _Pragma("unroll") for (int k_ = 0; k_ < 2; ++k_) { const int kp_ = hb2_ ? va_[k_ + 2] : va_[k_], sd_ = hb2_ ? va_[k_] : va_[k_ + 2]; vb_[k_] = kp_ + __builtin_amdgcn_update_dpp(0, sd_, 0x4E, 0xF, 0xF, true); } \
            const int kp1_ = hb1_ ? vb_[1] : vb_[0], sd1_ = hb1_ ? vb_[0] : vb_[1]; \
            const float mine_ = (float)(kp1_ + __builtin_amdgcn_update_dpp(0, sd1_, 0xB1, 0xF, 0xF, true)) * xs; \
              \
            pa[(pbase) + l8] = old_ + mine_; } while (0)
        const bool hb4_ = (l8 & 4) != 0, hb2_ = (l8 & 2) != 0, hb1_ = (l8 & 1) != 0;
        UD_LOADX(x, xs, tl, xg & 7);
        v4u iA[2], iB[2], rA[8], rB[8]; EX_IDS(iA, ip); EX_IDS(iB, ip + 8);
        EX_GATHER2(rA, iA, UF8, ub);
        for (int g = 0; g < 16; ++g) {
            const int gn = g < 15 ? g + 1 : 15, tln = wave * 8 + (lane >> 3) + 64 * (gn & 1), jn = ((gn >> 1) + xg) & 7;
            const unsigned ubn = 128u * (unsigned)jn + 16u * (unsigned)l8; const unsigned* ipn = idl + tln * 128;
            float* pa = dots + tl * 128;
            for (int p0 = 0; p0 < 128; p0 += 16) {
                const bool last = p0 == 112;
                const unsigned* ipx = last ? ipn : ip + p0 + 16;
                v4u iA2[2], iB2[2]; EX_IDS(iA2, ipx); EX_IDS(iB2, ipx + 8);
                if (last) UD_LOADX(xn, xsn, tln, jn);
                EX_GATHER2(rB, iB, UF8, ub); __builtin_amdgcn_sched_barrier(0);
                UD_CONSUME(rA, p0); __builtin_amdgcn_sched_barrier(0);
                { const unsigned ubx = last ? ubn : ub; EX_GATHER2(rA, iA2, UF8, ubx); } __builtin_amdgcn_sched_barrier(0);
                UD_CONSUME(rB, p0 + 8); __builtin_amdgcn_sched_barrier(0);
                iB[0] = iB2[0]; iB[1] = iB2[1];
            }
#pragma unroll
            for (int c = 0; c < 4; ++c) x[c] = xn[c];
            xs = xsn; tl = tln; ub = ubn; ip = ipn;
        }
#undef UD_CONSUME
#undef UD_LOADX
    }
    LDS_WAIT(); asm volatile("" ::: "memory");
#pragma unroll 1
    for (int k = 0; k < 2; ++k) { const int i8 = lane >> 3, tl = wave * 8 + i8 + 64 * k, base = tl * 128; const float r = RSTD[t0 + tl];
        unsigned char* blk = lds + (size_t)(64 * k + 8 * wave) * 512;
        float cf_[16]; int e_[16];
#pragma unroll
        for (int u = 0; u < 16; ++u) { cf_[u] = dots[base + l8 + 8 * u]; e_[u] = (int)(idl[base + l8 + 8 * u] >> 10); }
        LDS_WAIT(); asm volatile("" ::: "memory");
        float am = 0.f;
#pragma unroll
        for (int h = 0; h < 2; ++h) { float su_[8], sv_[8], g_[8];
#pragma unroll
            for (int u = 0; u < 8; ++u) { const int sl = l8 + 8 * (8 * h + u), e = e_[8 * h + u]; const f32x2 uv = SUV[e]; su_[u] = uv.x; sv_[u] = uv.y; g_[u] = GATE[(size_t)(t0 + tl) * 128 + sl]; }
#pragma unroll
            for (int u = 0; u < 8; ++u) { const float sdot = cf_[8 * h + u] * r * su_[u]; const float cf = 0.5f * sdot * (1.f + erff(sdot * 0.70710678118654752f)) * g_[u] * sv_[u];
                cf_[8 * h + u] = cf; am = fmaxf(am, fabsf(cf)); } }
        am = fmaxf(am, __builtin_bit_cast(float, __builtin_amdgcn_update_dpp(0, __builtin_bit_cast(int, am), 0xB1, 0xF, 0xF, true)));
        am = fmaxf(am, __builtin_bit_cast(float, __builtin_amdgcn_update_dpp(0, __builtin_bit_cast(int, am), 0x4E, 0xF, 0xF, true)));
        am = fmaxf(am, __builtin_bit_cast(float, __builtin_amdgcn_update_dpp(0, __builtin_bit_cast(int, am), 0x141, 0xF, 0xF, true)));
        const float qs = am > 0.f ? 448.f / am : 0.f;
        unsigned short* idt = (unsigned short*)(blk + 1024);
#pragma unroll
        for (int u = 0; u < 16; u += 2) { const int w = __builtin_amdgcn_cvt_pk_fp8_f32(cf_[u] * qs, cf_[u + 1] * qs, 0, false);
            const int x0 = (i8 * 4 + (l8 & 3)) * 32 + 2 * u + (l8 >> 2), x1 = x0 + 2;
            blk[x0] = (unsigned char)(w & 0xff); blk[x1] = (unsigned char)((w >> 8) & 0xff); idt[x0] = (unsigned short)e_[u]; idt[x1] = (unsigned short)e_[u + 1]; }
        if (l8 == 0) ((float*)(blk + 3072))[i8] = am * (1.f / 448.f);
    }
    LDS_WAIT(); asm volatile("" ::: "memory");
    EX_REPV {
        const int gq = lane >> 4, sp = (lane >> 3) & 1, ch = lane & 7;
        const unsigned mklo = ch < 4 ? (0xffu << (8 * ch)) : 0u, mkhi = ch >= 4 ? (0xffu << (8 * (ch - 4))) : 0u;
        const bool vld = (gq >> 1) == sp;
        f32x4 acc0 = {0.f, 0.f, 0.f, 0.f}, acc1 = {0.f, 0.f, 0.f, 0.f};
#define VP_ROW(p_) (((2 * ((p_) >> 1) + sp) * 4 + gq) * 32 + 16 * ((p_) & 1))
#define VM_STEP8(r, cl_, ch_) do { _Pragma("unroll") for (int i_ = 0; i_ < 8; ++i_) { const unsigned cwd_ = i_ < 4 ? (cl_) : (ch_); \
            const unsigned rep_ = __builtin_amdgcn_perm(cwd_, cwd_, 0x01010101u * (unsigned)(i_ & 3));       \
            const long am_ = (long)(((unsigned long)(rep_ & mkhi) << 32) | (unsigned long)(rep_ & mklo)); \
            const long b0_ = (long)(((unsigned long)r[i_].y << 32) | (unsigned long)r[i_].x), b1_ = (long)(((unsigned long)r[i_].w << 32) | (unsigned long)r[i_].z); \
            acc0 = __builtin_amdgcn_mfma_f32_16x16x32_fp8_fp8(am_, b0_, acc0, 0, 0, 0); acc1 = __builtin_amdgcn_mfma_f32_16x16x32_fp8_fp8(am_, b1_, acc1, 0, 0, 0); } } while (0)
        const unsigned char* blk = lds + (size_t)(8 * wave) * 512;
        int j = xg & 7;
        unsigned vb = 128u * (unsigned)j + 16u * (unsigned)ch;
        v4u iA, iB, rA[8], rB[8];
        { const unsigned short* ip0 = (const unsigned short*)(blk + 1024) + VP_ROW(0); iA = *(const v4u*)ip0; iB = *(const v4u*)(ip0 + 8); }
        EX_GATHER(rA, iA, VF8, vb);
        for (int g = 0; g < 16; ++g) {
            const int gn = g < 15 ? g + 1 : 15, jn = ((gn >> 1) + xg) & 7;
            const unsigned char* blkn = lds + (size_t)(64 * (gn & 1) + 8 * wave) * 512;
            const unsigned vbn = 128u * (unsigned)jn + 16u * (unsigned)ch;
            const int tw = t0 + wave * 8 + 64 * (g & 1);
#pragma unroll 1
            for (int tp = 0; tp < 4; ++tp) {
                const int t = tw + 2 * tp + sp;
                const bf16* xp = X1B + (size_t)t * D + 128 * j + 16 * ch + 4 * (gq & 1);
                const unsigned long xw0 = *(const unsigned long*)xp, xw1 = *(const unsigned long*)(xp + 8);
                const float osc = ((const float*)(blk + 3072))[2 * tp + sp];
#pragma unroll
                for (int hp = 0; hp < 2; ++hp) {
                    const int p = 2 * tp + hp; const bool last = p == 7;
                    const unsigned short* ipx = (const unsigned short*)((last ? blkn : blk) + 1024) + (last ? VP_ROW(0) : VP_ROW(p + 1));
                    const v4u iA2 = *(const v4u*)ipx, iB2 = *(const v4u*)(ipx + 8);
                    const v4u cw = *(const v4u*)(blk + VP_ROW(p));
                    EX_GATHER(rB, iB, VF8, vb); __builtin_amdgcn_sched_barrier(0);
                    VM_STEP8(rA, cw.x, cw.y); __builtin_amdgcn_sched_barrier(0);
                    { const unsigned vbx = last ? vbn : vb; EX_GATHER(rA, iA2, VF8, vbx); } __builtin_amdgcn_sched_barrier(0);
                    VM_STEP8(rB, cw.z, cw.w); __builtin_amdgcn_sched_barrier(0);
                    iB = iB2;
                }
                if (vld) { float* op = a.out + (size_t)t * D + 128 * j + 16 * ch + 4 * (gq & 1);
                    const unsigned a0 = (unsigned)xw0, a1 = (unsigned)(xw0 >> 32), b0 = (unsigned)xw1, b1 = (unsigned)(xw1 >> 32);
                    f32x4 o0, o1; o0.x = bflo(a0) + acc0.x * osc; o0.y = bfhi(a0) + acc0.y * osc; o0.z = bflo(a1) + acc0.z * osc; o0.w = bfhi(a1) + acc0.w * osc;
                    o1.x = bflo(b0) + acc1.x * osc; o1.y = bfhi(b0) + acc1.y * osc; o1.z = bflo(b1) + acc1.z * osc; o1.w = bfhi(b1) + acc1.w * osc;
                    *(f32x4*)op = o0; *(f32x4*)(op + 8) = o1; }
                acc0 = (f32x4){0.f, 0.f, 0.f, 0.f}; acc1 = (f32x4){0.f, 0.f, 0.f, 0.f};
            }
            blk = blkn; j = jn; vb = vbn;
        }
#undef VM_STEP8
#undef VP_ROW
    }
#undef EX_IDS
#undef EX_GATHER2
}

#ifndef PROBE_DUP
#define PROBE_DUP -1
#endif
#define REP(n) for (int rep_ = 0; rep_ < ((PROBE_DUP == (n)) ? 2 : 1); ++rep_, __syncthreads())
__global__ void __launch_bounds__(NWAVES * 64, 2) mega_fwd(Args args) {
    extern __shared__ __attribute__((aligned(16))) unsigned char lds[];
    const int tid = threadIdx.x, lane = tid & 63, wave = __builtin_amdgcn_readfirstlane(tid >> 6);
    const int G = gridDim.x, bx = blockIdx.x, vcu = (G % 8 == 0) ? (bx % 8) * (G / 8) + bx / 8 : bx;
    for (int u = tid; u < (LDS_BYTES - LDSCTL_OFF) / 4; u += NWAVES * 64) ((LAS unsigned*)((LAS unsigned char*)lds + LDSCTL_OFF))[u] = 0u;
    __syncthreads();
    volatile LAS unsigned* MISC = (volatile LAS unsigned*)((LAS unsigned char*)lds + MISC_OFF);
    XcdBarrier bar = xcd_barrier_post((unsigned*)(args.ws + WS_CTL) + CW_BAR, MISC + 8);
    unsigned char* ws = args.ws;
    const int gw = vcu * NWAVES + wave, NGW = G * NWAVES;

    REP(0) p0_prologue(args, lds, vcu, G, wave, lane, tid, 7);
#if PROBE_DUP >= 10 && PROBE_DUP <= 12
    __syncthreads(); p0_prologue(args, lds, vcu, G, wave, lane, tid, 1 << (PROBE_DUP - 10));
#endif
    xcd_barrier(bar);
    REP(1) { { int t2 = threadIdx.x; asm volatile("" : "+v"(t2)); p1_cumsum(args, lds, wave, t2 & 63, t2); }
    { pg8::Gemm g{(const pg8::bf16_t*)(ws + WS_XN), (const pg8::bf16_t*)(ws + WS_W1T), T, 2048, D}; pg8::StaticOrder S; S.init(T, 2048, G, bx);
      pg8::EpiQKV E{(pg8::bf16_t*)(ws + WS_ZP), args.in[4], args.in[5], (const float*)(ws + WS_R1)};
      pg8::gemm_phase<pg8::EpiQKV, pg8::StaticOrder, true, true>((LAS unsigned char*)lds, g, S, E); } }
    xcd_barrier(bar);
    REP(2) { const attn_body::AttnTensors AT{(const attn_body::bf16*)(ws + WS_Q), (const attn_body::bf16*)(ws + WS_K), (const attn_body::bf16*)(ws + WS_V), (attn_body::bf16*)(ws + WS_YC), (const float*)(ws + WS_FB)};
      attn_body::attn_phase_dyn<8>((char*)lds, AT, (unsigned*)(ws + WS_CTL) + 8192, args.in[4], args.in[5]); }
    REP(3) { int t2 = threadIdx.x; asm volatile("" : "+v"(t2)); p2_pool(args, vcu * NWAVES * 64 + t2, G * NWAVES * 64); }
    xcd_barrier(bar);
    REP(4) { if (vcu & 1) { int t2 = threadIdx.x; asm volatile("" : "+v"(t2)); p3_wsfold(args, lds, vcu, wave, t2); }
      pg8::Gemm g{(const pg8::bf16_t*)(ws + WS_YC), (const pg8::bf16_t*)(ws + WS_WOT), T, D, D}; pg8::StaticOrder S; S.init(T, D, G, bx);
      pg8::EpiX1 E{(const pg8::bf16_t*)(ws + WS_XN), args.out, (pg8::bf16_t*)(ws + WS_X1B), (float*)(ws + WS_RSQ)};
      pg8::gemm_phase<pg8::EpiX1, pg8::StaticOrder, true, true>((LAS unsigned char*)lds, g, S, E);
      if (!(vcu & 1)) { __syncthreads(); int t2 = threadIdx.x; asm volatile("" : "+v"(t2)); p3_wsfold(args, lds, vcu, wave, t2); } }
    xcd_barrier(bar);
    REP(5) { pg8::Gemm g{(const pg8::bf16_t*)(ws + WS_X1B), (const pg8::bf16_t*)(ws + WS_WST), T, 2048, D}; pg8::StaticOrder S; S.init(T, 2048, G, bx);
      pg8::EpiSc E{(pg8::bf16_t*)(ws + WS_SC)};
      pg8::gemm_phase<pg8::EpiSc, pg8::StaticOrder, true, true>((LAS unsigned char*)lds, g, S, E); }
    xcd_barrier(bar);
    REP(6) { int t2 = threadIdx.x; asm volatile("" : "+v"(t2)); p5_route(args, lds, gw, NGW, wave, t2 & 63); }
    xcd_barrier(bar);
    REP(7) { int t2 = threadIdx.x; asm volatile("" : "+v"(t2)); p6_experts(args, lds, bx, vcu, wave, t2 & 63, t2); }
}

extern "C" void kernel_launch(void* const* d_in, const int* in_sizes, int n_in, void* d_out, int out_size, void* d_ws, size_t ws_size, hipStream_t stream) {
    static int grid = 0;
    if (grid == 0) {
        if (n_in != 14 || in_sizes[0] != T * D || out_size != T * D || ws_size < WS_END) { fprintf(stderr, "kernel_launch: unexpected shapes (n_in %d, in0 %d, out %d, ws %zu)\n", n_in, n_in > 0 ? in_sizes[0] : -1, out_size, ws_size); grid = -1; return; }
        int dev = 0, cus = 0, per_cu = 0;
        if (hipGetDevice(&dev) != hipSuccess || hipDeviceGetAttribute(&cus, hipDeviceAttributeMultiprocessorCount, dev) != hipSuccess) { grid = -1; return; }
        if (hipFuncSetAttribute((const void*)mega_fwd, hipFuncAttributeMaxDynamicSharedMemorySize, LDS_BYTES) != hipSuccess) { fprintf(stderr, "kernel_launch: hipFuncSetAttribute failed\n"); grid = -1; return; }
        if (hipOccupancyMaxActiveBlocksPerMultiprocessor(&per_cu, (const void*)mega_fwd, NWAVES * 64, LDS_BYTES) != hipSuccess || per_cu < 1) fprintf(stderr, "kernel_launch: occupancy query reports %d per CU\n", per_cu);
        (void)hipGetLastError();
        grid = cus;
        if (grid != 256) { fprintf(stderr, "kernel_launch: unsupported CU count %d\n", grid); grid = -1; return; }
    }
    if (grid < 0) return;
    if (hipMemsetAsync((char*)d_ws + WS_CTL, 0, CTL_ZERO_BYTES, stream) != hipSuccess) return;
    Args a{};
    for (int i = 0; i < 14; ++i) a.in[i] = (const float*)d_in[i];
    a.out = (float*)d_out; a.ws = (unsigned char*)d_ws;
    hipLaunchKernelGGL(mega_fwd, dim3(grid), dim3(NWAVES * 64), LDS_BYTES, stream, a);
}
```

```cpp
#include <hip/hip_runtime.h>
#include <cstdio>
#include <cstdint>
#include <cmath>
namespace pg8 {
#define PG8_LAS __attribute__((address_space(3)))
typedef unsigned short bf16_t;
typedef short bf16x8 __attribute__((ext_vector_type(8)));
typedef float f32x4 __attribute__((ext_vector_type(4)));
typedef unsigned u32x4 __attribute__((ext_vector_type(4)));
constexpr int BM = 256, BK = 64, HALF = 128, HTB = HALF * BK * 2  , STAGE_BYTES = 8 * HTB, NXCD = 8, WGM = 8;

__host__ __device__ __forceinline__ int lds_byte(int r, int c) { const int st = (r >> 4) * 2 + (c >> 5), rr = r & 15, cc = c & 31, ob = rr * 64 + cc * 2; return st * 1024 + (ob ^ (((ob >> 9) & 1) << 5)); }
__host__ __device__ __forceinline__ void stage_rc(int b, int& R, int& C) { const int st = b / 1024, sb = b % 1024, swz = sb ^ (((sb >> 9) & 1) << 5); R = (st >> 1) * 16 + swz / 64; C = (st & 1) * 32 + (swz % 64) / 2; }
__host__ __device__ __forceinline__ int perm32(int rho) { const int n = rho >> 4, i = rho & 15; return 8 * (i >> 2) + 4 * n + (i & 3); }

struct Unit { int pm, pn; };
struct Gemm { const bf16_t* A; const bf16_t* Bt; int M, N, K; };

struct StaticOrder {
    int nM, nN, nwg, G, c;
    __host__ __device__ void init(int M, int N, int G_, int c_) { nM = M / BM; nN = N / BM; nwg = nM * nN; G = G_; c = c_; }
    __host__ __device__ bool next(int i, Unit& u) const {
        const long L = (long)i * G + c; if (L >= nwg) return false;
        int wgid = (int)L; { const int q = nwg / NXCD, r = nwg % NXCD, xcd = wgid % NXCD, off = wgid / NXCD; wgid = (xcd < r ? xcd * (q + 1) : r * (q + 1) + (xcd - r) * q) + off; }
        const int nig = WGM * nN, gid = wgid / nig, fm = gid * WGM, gsz = (nM - fm) < WGM ? (nM - fm) : WGM;
        u.pm = fm + ((wgid % nig) % gsz); u.pn = (wgid % nig) / gsz; return true;
    }
    __device__ __forceinline__ void a_ready(const Unit&) const {}
    __device__ __forceinline__ void done(const Unit&) const {}
};

__device__ __forceinline__ unsigned cvt_pk_bf16(float lo, float hi) { unsigned r; asm volatile("v_cvt_pk_bf16_f32 %0, %1, %2" : "=v"(r) : "v"(lo), "v"(hi)); return r; }
typedef float f32x2 __attribute__((ext_vector_type(2)));
__device__ __forceinline__ f32x2 gelu_pk(f32x2 v) {
    const f32x2 av = __builtin_elementwise_abs(v), d = av * 0.2316418882f + 1.0f;
    f32x2 t; t.x = __builtin_amdgcn_rcpf(d.x); t.y = __builtin_amdgcn_rcpf(d.y);
    f32x2 q = t * 0.5307027145f + (-0.7265760135f); q = q * t + 0.7107068705f; q = q * t + (-0.142248368f); q = q * t + 0.127414796f; q = q * t;
    const f32x2 s = (v * v) * (-0.72134752044f);
    f32x2 e; e.x = __builtin_amdgcn_exp2f(s.x); e.y = __builtin_amdgcn_exp2f(s.y);
    const f32x2 m = v * (q * e), r = v - m;
    f32x2 o; o.x = v.x < 0.f ? m.x : r.x; o.y = v.y < 0.f ? m.y : r.y; return o;
}

template <int ACT  > struct EpiBf16 {
    static constexpr bool PERM = true, AFTER_DRAIN = false; static_assert(ACT == 0 || ACT == 1, "EpiBf16: ACT is 0 (none) or 1 (gelu_pk)");
    bf16_t* O; int ldc; const float* bias; int split_cols; size_t split_stride; float scale0;
    __device__ __forceinline__ void operator()(const f32x4 (&acc)[2][2][4][2], const Unit& u, int wr, int wc, int fr, int fq) const {
        const int row0 = u.pm * BM + wr * 64 + fr; int colt = u.pn * BM; bf16_t* base = O;
        float sc = 1.f; if (split_cols) { const int t = colt / split_cols; base += (size_t)t * split_stride; colt -= t * split_cols; if (t == 0) sc = scale0; }
        const int col0 = colt + wc * 32 + 8 * fq, bcol0 = u.pn * BM + wc * 32 + 8 * fq;
        f32x4 bv[2][2];
#pragma unroll
        for (int bj = 0; bj < 2; ++bj)
#pragma unroll
            for (int n = 0; n < 2; ++n) bv[bj][n] = bias ? *(const f32x4*)(bias + bcol0 + bj * HALF + 4 * n) : (f32x4){0.f, 0.f, 0.f, 0.f};
#pragma unroll
        for (int ai = 0; ai < 2; ++ai)
#pragma unroll
            for (int m = 0; m < 4; ++m) { bf16_t* rowp = base + (size_t)(row0 + ai * HALF + m * 16) * ldc + col0;
#pragma unroll
                for (int bj = 0; bj < 2; ++bj) { f32x4 v0 = acc[ai][bj][m][0] + bv[bj][0], v1 = acc[ai][bj][m][1] + bv[bj][1];
                    if (ACT == 1) { f32x2 a = gelu_pk((f32x2){v0[0], v0[1]}), b = gelu_pk((f32x2){v0[2], v0[3]}), c = gelu_pk((f32x2){v1[0], v1[1]}), d = gelu_pk((f32x2){v1[2], v1[3]});
                        v0 = (f32x4){a.x, a.y, b.x, b.y}; v1 = (f32x4){c.x, c.y, d.x, d.y}; }
                    v0 = v0 * sc; v1 = v1 * sc; u32x4 w; w.x = cvt_pk_bf16(v0[0], v0[1]); w.y = cvt_pk_bf16(v0[2], v0[3]); w.z = cvt_pk_bf16(v1[0], v1[1]); w.w = cvt_pk_bf16(v1[2], v1[3]);
                    *(u32x4*)(rowp + bj * HALF) = w; } }
    }
};
template <class Epi, class Sched, bool ALIGN_EPI = false, bool SP2 = false>
__device__ __forceinline__ void gemm_phase(PG8_LAS unsigned char* lds, const Gemm g, const Sched& S, const Epi& E) {
    int tid_ = threadIdx.x; asm volatile("" : "+v"(tid_));
    const int tid = tid_, wid = __builtin_amdgcn_readfirstlane(tid >> 6), lane = tid & 63, wr = wid >> 2, wc = wid & 3, fr = lane & 15, fq = lane >> 4;
    const int K = g.K, nt = K / BK;
    unsigned voffA[2], voffB[2];
#pragma unroll
    for (int i = 0; i < 2; ++i) { int R, C; stage_rc(tid * 16 + i * 8192, R, C); const int Rb = Epi::PERM ? ((R & ~31) + perm32(R & 31)) : R;
        voffA[i] = (unsigned)(R * K + C) * 2u; voffB[i] = (unsigned)(Rb * K + C) * 2u; }
    const size_t kstep = (size_t)(BK * 2);
    const size_t hstep = (size_t)HALF * K * 2;
    const size_t tstep = 2 * hstep;
    const unsigned ldsw = (unsigned)wid * 1024u;
    const int aoff = lds_byte(wr * 64 + fr, fq * 8), boff = lds_byte(wc * 32 + fr, fq * 8);
#define PG8_SA(b, h) (((b) * 2 + (h)) * HTB)
#define PG8_SB(b, h) ((4 + (b) * 2 + (h)) * HTB)
#define PG8_STAGE(bufoff, gbase, voff) do { _Pragma("unroll") for (int _i = 0; _i < 2; ++_i) \
        __builtin_amdgcn_global_load_lds((const unsigned*)((const char*)(gbase) + (voff)[_i]), (PG8_LAS unsigned*)(lds + (bufoff) + ldsw + _i * 8192), 16, 0, 0); } while (0)
#define PG8_LDA(dst, b, h) do { _Pragma("unroll") for (int m = 0; m < 4; ++m) _Pragma("unroll") for (int k = 0; k < 2; ++k) dst[m][k] = *(const PG8_LAS bf16x8*)(lds + PG8_SA(b, h) + aoff + m * 2048 + k * 1024); } while (0)
#define PG8_LDB(dst, b, h) do { _Pragma("unroll") for (int n = 0; n < 2; ++n) _Pragma("unroll") for (int k = 0; k < 2; ++k) dst[n][k] = *(const PG8_LAS bf16x8*)(lds + PG8_SB(b, h) + boff + n * 2048 + k * 1024); } while (0)
#define PG8_MMA(ai, bj, At, Bt) do { __builtin_amdgcn_s_setprio(1); _Pragma("unroll") for (int m = 0; m < 4; ++m) _Pragma("unroll") for (int n = 0; n < 2; ++n) _Pragma("unroll") for (int k = 0; k < 2; ++k) \
        acc[ai][bj][m][n] = __builtin_amdgcn_mfma_f32_16x16x32_bf16(Bt[n][k], At[m][k], acc[ai][bj][m][n], 0, 0, 0); __builtin_amdgcn_s_setprio(0); } while (0)
#define PG8_WAIT_V(n) asm volatile("s_waitcnt vmcnt(" #n ")" ::: "memory")
#define PG8_WAIT_L(n) asm volatile("s_waitcnt lgkmcnt(" #n ")" ::: "memory")
#define PG8_BAR __builtin_amdgcn_s_barrier()
#define PG8_SCHED __builtin_amdgcn_sched_barrier(0)
    Unit cur, nxt; int ui = 0;
    if (!S.next(0, cur)) return;
    f32x4 acc[2][2][4][2];
#pragma unroll
    for (int a = 0; a < 2; ++a)
#pragma unroll
        for (int b = 0; b < 2; ++b)
#pragma unroll
            for (int m = 0; m < 4; ++m)
#pragma unroll
                for (int n = 0; n < 2; ++n) acc[a][b][m][n] = (f32x4){0.f, 0.f, 0.f, 0.f};
    bf16x8 At[4][2], B0[2][2], B1[2][2];
    const char* cA = (const char*)g.A + (size_t)cur.pm * tstep; const char* cB = (const char*)g.Bt + (size_t)cur.pn * tstep;
    S.a_ready(cur);
    if constexpr (SP2) {
        PG8_STAGE(PG8_SB(0, 0), cB, voffB); PG8_STAGE(PG8_SB(0, 1), cB + hstep, voffB); PG8_STAGE(PG8_SA(0, 0), cA, voffA); PG8_STAGE(PG8_SA(0, 1), cA + hstep, voffA);
        if (wr == 1) PG8_BAR;
        PG8_WAIT_V(2); PG8_BAR;
        PG8_STAGE(PG8_SB(1, 0), cB + kstep, voffB); PG8_STAGE(PG8_SA(1, 0), cA + kstep, voffA); PG8_STAGE(PG8_SB(1, 1), cB + hstep + kstep, voffB);
        PG8_WAIT_V(6); PG8_BAR;
    } else {
        PG8_STAGE(PG8_SB(0, 0), cB, voffB); PG8_STAGE(PG8_SA(0, 0), cA, voffA); PG8_STAGE(PG8_SB(0, 1), cB + hstep, voffB); PG8_STAGE(PG8_SA(0, 1), cA + hstep, voffA);
        if (wr == 1) PG8_BAR;
        PG8_WAIT_V(4); PG8_BAR;
        PG8_STAGE(PG8_SB(1, 0), cB + kstep, voffB); PG8_STAGE(PG8_SA(1, 0), cA + kstep, voffA); PG8_STAGE(PG8_SB(1, 1), cB + hstep + kstep, voffB);
        PG8_WAIT_V(6); PG8_BAR;
    }
    for (;;) {
        const bool has_next = S.next(ui + 1, nxt);
        const char* nA = has_next ? (const char*)g.A + (size_t)nxt.pm * tstep : cA; const char* nB = has_next ? (const char*)g.Bt + (size_t)nxt.pn * tstep : cB;
        for (int t = 0; t < nt; t += 2) {
            const bool last = (t == nt - 2);
            const char* a1 = cA + (size_t)(t + 1) * kstep;
            const char* a2 = last ? nA : cA + (size_t)(t + 2) * kstep; const char* b2 = last ? nB : cB + (size_t)(t + 2) * kstep;
            const char* a3 = a2 + kstep; const char* b3 = b2 + kstep;
            if (last && has_next) S.a_ready(nxt);
            if constexpr (SP2) {
            PG8_LDB(B0, 0, 0); PG8_LDB(B1, 0, 1); PG8_SCHED; PG8_LDA(At, 0, 0); PG8_STAGE(PG8_SA(1, 1), a1 + hstep, voffA);
            PG8_WAIT_V(8); PG8_WAIT_L(0); PG8_BAR; PG8_MMA(0, 0, At, B0); PG8_MMA(0, 1, At, B1); PG8_BAR; PG8_SCHED;
            PG8_LDA(At, 0, 1); PG8_STAGE(PG8_SB(0, 0), b2, voffB); PG8_STAGE(PG8_SB(0, 1), b2 + hstep, voffB); PG8_STAGE(PG8_SA(0, 0), a2, voffA);
            PG8_WAIT_V(8); PG8_WAIT_L(0); PG8_BAR; PG8_MMA(1, 0, At, B0); PG8_MMA(1, 1, At, B1); PG8_BAR; PG8_SCHED;
            PG8_LDB(B0, 1, 0); PG8_LDB(B1, 1, 1); PG8_SCHED; PG8_LDA(At, 1, 0); PG8_STAGE(PG8_SA(0, 1), a2 + hstep, voffA);
            PG8_WAIT_V(8); PG8_WAIT_L(0); PG8_BAR; PG8_MMA(0, 0, At, B0); PG8_MMA(0, 1, At, B1); PG8_BAR; PG8_SCHED;
            PG8_LDA(At, 1, 1); PG8_STAGE(PG8_SB(1, 0), b3, voffB); PG8_STAGE(PG8_SB(1, 1), b3 + hstep, voffB); PG8_STAGE(PG8_SA(1, 0), a3, voffA);
            PG8_WAIT_V(8); PG8_WAIT_L(0); PG8_BAR; PG8_MMA(1, 0, At, B0); PG8_MMA(1, 1, At, B1); PG8_BAR; PG8_SCHED;
            } else {
            PG8_LDB(B0, 0, 0); PG8_SCHED; PG8_LDA(At, 0, 0); PG8_STAGE(PG8_SA(1, 1), a1 + hstep, voffA);
            PG8_WAIT_L(8); PG8_BAR; PG8_WAIT_L(0); PG8_MMA(0, 0, At, B0); PG8_BAR; PG8_SCHED;
            PG8_LDB(B1, 0, 1); PG8_STAGE(PG8_SB(0, 0), b2, voffB);
            PG8_BAR; PG8_WAIT_L(0); PG8_MMA(0, 1, At, B1); PG8_BAR;
            PG8_LDA(At, 0, 1); PG8_STAGE(PG8_SA(0, 0), a2, voffA);
            PG8_BAR; PG8_WAIT_L(0); PG8_MMA(1, 0, At, B0); PG8_BAR; PG8_SCHED;
            PG8_STAGE(PG8_SB(0, 1), b2 + hstep, voffB);
            PG8_WAIT_V(6); PG8_BAR; PG8_MMA(1, 1, At, B1); PG8_BAR;
            PG8_LDB(B0, 1, 0); PG8_SCHED; PG8_LDA(At, 1, 0); PG8_STAGE(PG8_SA(0, 1), a2 + hstep, voffA);
            PG8_WAIT_L(8); PG8_BAR; PG8_WAIT_L(0); PG8_MMA(0, 0, At, B0); PG8_BAR; PG8_SCHED;
            PG8_LDB(B1, 1, 1); PG8_STAGE(PG8_SB(1, 0), b3, voffB);
            PG8_BAR; PG8_WAIT_L(0); PG8_MMA(0, 1, At, B1); PG8_BAR;
            PG8_LDA(At, 1, 1); PG8_STAGE(PG8_SA(1, 0), a3, voffA);
            PG8_BAR; PG8_WAIT_L(0); PG8_MMA(1, 0, At, B0); PG8_BAR; PG8_SCHED;
            PG8_STAGE(PG8_SB(1, 1), b3 + hstep, voffB);
            PG8_WAIT_V(6); PG8_BAR; PG8_MMA(1, 1, At, B1); PG8_BAR;
            }
        }
        if constexpr (ALIGN_EPI) { if (wr == 0) PG8_BAR; }
        if constexpr (!Epi::AFTER_DRAIN) { E(acc, cur, wr, wc, fr, fq); S.done(cur); }
        if (!has_next) break;
#pragma unroll
        for (int a = 0; a < 2; ++a)
#pragma unroll
            for (int b = 0; b < 2; ++b)
#pragma unroll
                for (int m = 0; m < 4; ++m)
#pragma unroll
                    for (int n = 0; n < 2; ++n) acc[a][b][m][n] = (f32x4){0.f, 0.f, 0.f, 0.f};
        cur = nxt; cA = nA; cB = nB; ++ui;
        if constexpr (ALIGN_EPI) { if (wr == 1) PG8_BAR; }
    }
    PG8_WAIT_V(0);
    if constexpr (!ALIGN_EPI) { if (wr == 0) PG8_BAR; }
    PG8_BAR;
    if constexpr (Epi::AFTER_DRAIN) { E.fused(acc, cur, wr, wc, fr, fq, lds, wid, lane); S.done(cur); }
#undef PG8_SA
#undef PG8_SB
#undef PG8_STAGE
#undef PG8_LDA
#undef PG8_LDB
#undef PG8_MMA
#undef PG8_WAIT_V
#undef PG8_WAIT_L
#undef PG8_BAR
#undef PG8_SCHED
}
}
#include <hip/hip_bf16.h>
#include <cmath>
namespace attn_body {
using bf16=__hip_bfloat16;
using bf16x8=__attribute__((ext_vector_type(8)))short;
using s16x4=__attribute__((ext_vector_type(4)))short;
using f32x16=__attribute__((ext_vector_type(16)))float;
using u32x4=__attribute__((ext_vector_type(4)))unsigned;
using f32x4=__attribute__((ext_vector_type(4)))float;
constexpr int BATCH=16,NHEAD=8,SEQ=2048,D=64,DM=NHEAD*D,OPITCH=1024,OCOL=512;
constexpr int NW=8,QBLK=32,QB=QBLK*NW,KVBLK=64,NQB=SEQ/QB;
constexpr int ATTN_PITCH=DM, ATTN_UNIT_ROWS=QB;
__device__ __forceinline__ int crow(int r,int hi){return (r&3)+8*(r>>2)+4*hi;}
#define SBAR() __builtin_amdgcn_sched_barrier(0)
__device__ __forceinline__ void cmask(f32x16&p0,f32x16&p1,int jb,int qrel,int hi){
  const float NEG=-INFINITY; int kb=64*jb+4*hi;
  #pragma unroll
  for(int r=0;r<16;++r){int kv=kb+(r&3)+8*(r>>2); if(kv>qrel)p0[r]=NEG; if(kv+32>qrel)p1[r]=NEG;}
}

constexpr int NSLOT=3, SLOTB=8192;
constexpr int LDS_K=0, LDS_V=NSLOT*SLOTB, LDS_WS=2*NSLOT*SLOTB, LDS_OST=LDS_WS+NW*64*4, LDS_BIAS=LDS_OST+NW*4096, LDS_BYTES=LDS_BIAS+SEQ*4;
constexpr float C2=0.125f*1.4426950408889634f;
__device__ __forceinline__ void glds16(const void*gsrc,unsigned lds_dst){unsigned keep;
  asm volatile("s_mov_b32 %0, m0\n\ts_mov_b32 m0, %2\n\ts_nop 0\n\tglobal_load_lds_dwordx4 %1, off\n\ts_mov_b32 m0, %0":"=&s"(keep):"v"(gsrc),"s"(lds_dst):"memory");}
__device__ __forceinline__ float max3f(float a,float b,float c){float r;asm("v_max3_f32 %0, %1, %2, %3":"=v"(r):"v"(a),"v"(b),"v"(c));return r;}
__device__ __forceinline__ float max2f(float a,float b){float r;asm("v_max_f32_e32 %0, %1, %2":"=v"(r):"v"(a),"v"(b));return r;}
__device__ __forceinline__ float fadd_s(float a,float b){float r;asm("v_add_f32_e32 %0, %1, %2":"=v"(r):"v"(a),"v"(b));return r;}
__device__ __forceinline__ float fsub_s(float a,float b){float r;asm("v_sub_f32_e32 %0, %1, %2":"=v"(r):"v"(a),"v"(b));return r;}
typedef float f32x2_t __attribute__((ext_vector_type(2))); typedef __bf16 bf16x2_t __attribute__((ext_vector_type(2)));
__device__ __forceinline__ unsigned cvtpk_s(float lo,float hi){f32x2_t v={lo,hi};bf16x2_t b=__builtin_convertvector(v,bf16x2_t);return __builtin_bit_cast(unsigned,b);}
#define WAIT_BAR(N) asm volatile("s_waitcnt vmcnt(" #N ") lgkmcnt(0)\n\ts_barrier":::"memory")

__device__ __forceinline__ void qkt(f32x16&p0,f32x16&p1,const char*Kslot,const bf16x8*qr,int r32,int hi){
  const char*kb=Kslot+hi*1024+r32*16;
  #pragma unroll
  for(int d0=0;d0<4;++d0){
    const bf16x8 b0=*reinterpret_cast<const bf16x8*>(kb+d0*2048);
    const bf16x8 b1=*reinterpret_cast<const bf16x8*>(kb+d0*2048+512);
    {p0=__builtin_amdgcn_mfma_f32_32x32x16_bf16(b0,qr[d0],p0,0,0,0);p1=__builtin_amdgcn_mfma_f32_32x32x16_bf16(b1,qr[d0],p1,0,0,0);}}
}
typedef __attribute__((address_space(3))) const char* lds_cptr;
typedef short v4i16_t __attribute__((ext_vector_type(4)));
__device__ __forceinline__ void kload8(bf16x8*kf,lds_cptr kp){
  kf[0]=*(const __attribute__((address_space(3))) bf16x8*)(kp);      kf[1]=*(const __attribute__((address_space(3))) bf16x8*)(kp+512);
  kf[2]=*(const __attribute__((address_space(3))) bf16x8*)(kp+2048); kf[3]=*(const __attribute__((address_space(3))) bf16x8*)(kp+2560);
  kf[4]=*(const __attribute__((address_space(3))) bf16x8*)(kp+4096); kf[5]=*(const __attribute__((address_space(3))) bf16x8*)(kp+4608);
  kf[6]=*(const __attribute__((address_space(3))) bf16x8*)(kp+6144); kf[7]=*(const __attribute__((address_space(3))) bf16x8*)(kp+6656);
}
__device__ __forceinline__ void kload2(bf16x8*kf,lds_cptr kp,int j){ kf[2*j]=*(const __attribute__((address_space(3))) bf16x8*)(kp+j*2048); kf[2*j+1]=*(const __attribute__((address_space(3))) bf16x8*)(kp+j*2048+512); }
__device__ __forceinline__ s16x4 vtr(lds_cptr p){ return __builtin_bit_cast(s16x4,__builtin_amdgcn_ds_read_tr16_b64_v4i16((__attribute__((address_space(3))) v4i16_t*)p)); }
__device__ __forceinline__ float rowmax(const f32x16&p0,const f32x16&p1){
  float a=max3f(p0[0],p0[1],p1[0]),b=max3f(p0[2],p0[3],p1[1]);a=max3f(a,p1[2],p1[3]);
  #pragma unroll
  for(int r=4;r<16;r+=4){a=max3f(a,p0[r],p0[r+1]);b=max3f(b,p0[r+2],p0[r+3]);a=max3f(a,p1[r],p1[r+1]);b=max3f(b,p1[r+2],p1[r+3]);}
  const float m=max2f(a,b);
  auto rr=__builtin_amdgcn_permlane32_swap(__float_as_uint(m),__float_as_uint(m),false,false);
  return max2f(__uint_as_float(rr[0]),__uint_as_float(rr[1]));
}
__device__ __forceinline__ void pv(f32x16*o,int vb,bf16x8 pa0,bf16x8 pa1,bf16x8 pa2,bf16x8 pa3){
  #pragma unroll
  for(int d0=0;d0<2;++d0){s16x4 lo[4],hi[4];
    #pragma unroll
    for(int ks=0;ks<4;++ks){
      asm volatile("ds_read_b64_tr_b16 %0,%1 offset:%c2":"=&v"(lo[ks]):"v"(vb),"i"(d0*4096+ks*1024):"memory");
      asm volatile("ds_read_b64_tr_b16 %0,%1 offset:%c2":"=&v"(hi[ks]):"v"(vb),"i"(d0*4096+ks*1024+512):"memory");}
    asm volatile("s_waitcnt lgkmcnt(0)":::"memory");SBAR();
    #define PK(k) (bf16x8){lo[k][0],lo[k][1],lo[k][2],lo[k][3],hi[k][0],hi[k][1],hi[k][2],hi[k][3]}
    o[d0]=__builtin_amdgcn_mfma_f32_32x32x16_bf16(pa0,PK(0),o[d0],0,0,0);
    o[d0]=__builtin_amdgcn_mfma_f32_32x32x16_bf16(pa1,PK(1),o[d0],0,0,0);
    o[d0]=__builtin_amdgcn_mfma_f32_32x32x16_bf16(pa2,PK(2),o[d0],0,0,0);
    o[d0]=__builtin_amdgcn_mfma_f32_32x32x16_bf16(pa3,PK(3),o[d0],0,0,0);
    #undef PK
  }
}

#ifndef ATTN_STORE16
#define ATTN_STORE16(p,v) (*(u32x4*)(p)=(v))
#endif
template<int THRL> __device__ __forceinline__ void attn_unit(int b,int h,int qb,const bf16*Q,const bf16*__restrict__ K,const bf16*__restrict__ V,bf16*O,const float*__restrict__ FBh,float qkmax,unsigned*ctr,char*shm){
  int tid_=threadIdx.x; asm volatile("":"+v"(tid_));
  const int tid=tid_,lane=tid&63,r32=lane&31,hi=lane>>5; const int wid=__builtin_amdgcn_readfirstlane(tid>>6);
  const long rowbase=(long)b*SEQ; const int q0=qb*QB;
  const bf16*Qw=Q+(rowbase+q0+wid*QBLK)*DM+h*D;
  const int NT0=(q0+QB)/KVBLK; int ts;
  { const float bq0=FBh[q0]; const float be=FBh[64*(lane<NT0?lane:NT0-1)+63]; const unsigned long long mk=__ballot(lane<NT0&&(bq0-be>150.f));
    ts=__builtin_popcountll(mk)&~1; ts=ts<NT0-4?ts:NT0-4; ts=__builtin_amdgcn_readfirstlane(ts); }
  const bf16*Kh=K+(rowbase+(long)ts*KVBLK)*DM+h*D,*Vh=V+(rowbase+(long)ts*KVBLK)*DM+h*D;
  const unsigned lds0=(unsigned)(uintptr_t)shm;
  float*wsf=(float*)(shm+LDS_WS)+wid*64;
  const bf16*ksrc=Kh+(long)lane*DM+wid*8;
  const bf16*vsrc=Vh+(long)(16*(wid&3)+(lane>>2))*DM+(wid>>2)*32+(lane&3)*8;
  const unsigned kdst=lds0+LDS_K+wid*1024, vdst=lds0+LDS_V+wid*1024;
  #define DMA_K(t,slot) glds16(ksrc+(long)(t)*KVBLK*DM,(unsigned)__builtin_amdgcn_readfirstlane(kdst+(slot)))
  #define DMA_V(t,slot) glds16(vsrc+(long)(t)*KVBLK*DM,(unsigned)__builtin_amdgcn_readfirstlane(vdst+(slot)))
  const int vb0=(int)(lds0+LDS_V)+((lane>>4)&1)*32+(lane&3)*8+(4*hi+((lane&15)>>2))*64;
  const char*Kbase=shm+LDS_K; bf16x8 kf[8];
  const lds_cptr shm3=(lds_cptr)shm; const lds_cptr kp0=shm3+LDS_K+hi*1024+r32*16; const lds_cptr vp0=shm3+LDS_V+((lane>>4)&1)*32+(lane&3)*8+(4*hi+((lane&15)>>2))*64;
  const int NT=NT0-ts;
  DMA_K(0,0);DMA_V(0,0);DMA_K(1,SLOTB);
  bf16x8 qr[4];
  #pragma unroll
  for(int d0=0;d0<4;++d0)qr[d0]=*reinterpret_cast<const bf16x8*>(&Qw[(long)r32*DM+d0*16+hi*8]);
  { float*bl=(float*)(shm+LDS_BIAS); int t4=tid; asm volatile("":"+v"(t4)); t4*=4;
    if(t4<q0+QB){ const f32x4 v_=*reinterpret_cast<const f32x4*>(FBh+t4); *reinterpret_cast<f32x4*>(bl+t4)=v_; } }
  const lds_cptr bp0=shm3+LDS_BIAS+16*hi+256*ts;
  #define BIASC(C0,C1,t) do{ const lds_cptr bp_=bp0+256*(t); _Pragma("unroll") for(int g_=0;g_<4;++g_){ \
    const f32x4 a_=*(const __attribute__((address_space(3))) f32x4*)(bp_+32*g_); const f32x4 b_=*(const __attribute__((address_space(3))) f32x4*)(bp_+128+32*g_); \
    C0[4*g_]=a_[0]; C0[4*g_+1]=a_[1]; C0[4*g_+2]=a_[2]; C0[4*g_+3]=a_[3]; C1[4*g_]=b_[0]; C1[4*g_+1]=b_[1]; C1[4*g_+2]=b_[2]; C1[4*g_+3]=b_[3]; } }while(0)
  float mhat=0.f,l_reg=0.f;f32x16 o[2];o[0]=f32x16{};o[1]=f32x16{};
  const int qrel=wid*QBLK+r32;
  #define CMASK(P0,P1,t) do{int jb_=(t)-(NT-4); if(jb_>=0)cmask(P0,P1,jb_,qrel,hi);}while(0)
  bool resc=false;
  #define START(P0,P1) do{ resc=false; \
    { const float dl=mhat; \
      _Pragma("unroll") for(int r=0;r<16;++r){P0[r]=fsub_s(P0[r],dl);P1[r]=fsub_s(P1[r],dl);} \
      } \
    _Pragma("unroll") for(int r=0;r<16;++r)P0[r]=__builtin_amdgcn_exp2f(P0[r]); }while(0)
  #define RESC() do{ if(resc){ asm volatile("s_waitcnt lgkmcnt(0)":::"memory"); \
      _Pragma("unroll") for(int d_=0;d_<2;++d_) _Pragma("unroll") for(int r=0;r<16;++r)o[d_][r]*=wsf[crow(r,hi)]; } }while(0)
  f32x16 pA0,pA1,pB0,pB1;
  int sl_prev=0,sl_cur=0,sl_next=SLOTB;
  #define ROT() do{sl_prev=sl_cur;sl_cur=sl_next;sl_next=(sl_next==(NSLOT-1)*SLOTB)?0:sl_next+SLOTB;}while(0)
  DMA_K(2,2*SLOTB);
  WAIT_BAR(3);
  mhat=((const float*)(shm+LDS_BIAS))[q0+qrel]+qkmax;
  BIASC(pA0,pA1,0); qkt(pA0,pA1,Kbase,qr,r32,hi);asm volatile("s_nop 15\n\ts_nop 7":"+v"(pA0),"+v"(pA1));CMASK(pA0,pA1,0);
  START(pA0,pA1);
  _Pragma("unroll") for(int r=0;r<16;++r)pA1[r]=__builtin_amdgcn_exp2f(pA1[r]);
  WAIT_BAR(0);
  DMA_K(3,0);DMA_V(1,SLOTB);
  ROT();
  kload8(kf,kp0+sl_cur);
  WAIT_BAR(2);
  s16x4 vlo[8],vhi[8]; u32x4 pw0,pw1,pw2,pw3;
  #define PKW(P,B) cvtpk_s(P[B],P[B+1])
  #define PAF(k) __builtin_bit_cast(bf16x8,pw##k)
  #define VFR(i) (bf16x8){vlo[i][0],vlo[i][1],vlo[i][2],vlo[i][3],vhi[i][0],vhi[i][1],vhi[i][2],vhi[i][3]}
  #define PIN(x) asm volatile("":"+v"(x))
  #define MX3(a,b,c) __builtin_fmaxf(__builtin_fmaxf((a),(b)),(c))
  #define GAPA(MF,A0,A1,A2,A3,W0,W1,PW) do{ MF; sacc+=A0; sacc+=A1; sacc+=A2; sacc+=A3; PIN(sacc); W0; W1; PIN(PW); SBAR(); }while(0)
  #define EX(v) __builtin_amdgcn_exp2f(v)
  #define GAPB(MF,X,B) do{ MF; X[B]=EX(X[B]-mhat); X[B+1]=EX(X[B+1]-mhat); X[B+2]=EX(X[B+2]-mhat); X[B+3]=EX(X[B+3]-mhat); PIN(X); SBAR(); }while(0)
  #define VRD(i) do{ vlo[i]=vtr(vp_+(((i)>>2)*4096+((i)&3)*1024)); vhi[i]=vtr(vp_+(((i)>>2)*4096+((i)&3)*1024+512)); }while(0)
  #define KRD(G,j) do{ if(G){ kload2(kf,kp0+sl_next,j); SBAR(); } }while(0)
  #define STEP(C0,C1,P0,P1,t,GK,GV,GL) do{ BIASC(C0,C1,t); SBAR(); \
    const lds_cptr vp_=vp0+sl_prev; \
    VRD(0); SBAR(); float sacc=(P0[0]+P0[1]); \
    GAPA(C0=__builtin_amdgcn_mfma_f32_32x32x16_bf16(kf[0],qr[0],C0,0,0,0), P0[2],P0[3],P0[4],P0[5],     pw0[0]=PKW(P0,0), pw0[1]=PKW(P0,2), pw0); \
    VRD(4); SBAR(); GAPA(C1=__builtin_amdgcn_mfma_f32_32x32x16_bf16(kf[1],qr[0],C1,0,0,0), P0[6],P0[7],P0[8],P0[9],     pw0[2]=PKW(P0,4), pw0[3]=PKW(P0,6), pw0); \
    VRD(1); SBAR(); GAPA(C0=__builtin_amdgcn_mfma_f32_32x32x16_bf16(kf[2],qr[1],C0,0,0,0),   P0[10],P0[11],P0[12],P0[13], pw1[0]=PKW(P0,8), pw1[1]=PKW(P0,10), pw1); \
    VRD(5); SBAR(); GAPA(C1=__builtin_amdgcn_mfma_f32_32x32x16_bf16(kf[3],qr[1],C1,0,0,0),   P0[14],P0[15],P1[0],P1[1],   pw1[2]=PKW(P0,12),pw1[3]=PKW(P0,14), pw1); \
    VRD(2); SBAR(); GAPA(C0=__builtin_amdgcn_mfma_f32_32x32x16_bf16(kf[4],qr[2],C0,0,0,0),   P1[2],P1[3],P1[4],P1[5],     pw2[0]=PKW(P1,0), pw2[1]=PKW(P1,2), pw2); \
    VRD(6); SBAR(); GAPA(C1=__builtin_amdgcn_mfma_f32_32x32x16_bf16(kf[5],qr[2],C1,0,0,0),   P1[6],P1[7],P1[8],P1[9],     pw2[2]=PKW(P1,4), pw2[3]=PKW(P1,6), pw2); \
    VRD(3); SBAR(); GAPA(C0=__builtin_amdgcn_mfma_f32_32x32x16_bf16(kf[6],qr[3],C0,0,0,0),   P1[10],P1[11],P1[12],P1[13], pw3[0]=PKW(P1,8), pw3[1]=PKW(P1,10), pw3); \
    VRD(7); SBAR(); GAPA(C1=__builtin_amdgcn_mfma_f32_32x32x16_bf16(kf[7],qr[3],C1,0,0,0),   P1[14],P1[15],0.f,0.f,       pw3[2]=PKW(P1,12),pw3[3]=PKW(P1,14), pw3); \
    l_reg+=sacc; \
    if(GK){DMA_K((t)+3,sl_cur);} if(GV){DMA_V((t)+1,sl_next);} \
    CMASK(C0,C1,t); \
    SBAR(); \
    GAPB(o[0]=__builtin_amdgcn_mfma_f32_32x32x16_bf16(PAF(0),VFR(0),o[0],0,0,0), C0,0); \
    GAPB(o[1]=__builtin_amdgcn_mfma_f32_32x32x16_bf16(PAF(0),VFR(4),o[1],0,0,0), C0,4); \
    KRD(GL,0); GAPB(o[0]=__builtin_amdgcn_mfma_f32_32x32x16_bf16(PAF(1),VFR(1),o[0],0,0,0), C0,8); \
    KRD(GL,1); GAPB(o[1]=__builtin_amdgcn_mfma_f32_32x32x16_bf16(PAF(1),VFR(5),o[1],0,0,0), C0,12); \
    KRD(GL,2); GAPB(o[0]=__builtin_amdgcn_mfma_f32_32x32x16_bf16(PAF(2),VFR(2),o[0],0,0,0), C1,0); \
    KRD(GL,3); GAPB(o[1]=__builtin_amdgcn_mfma_f32_32x32x16_bf16(PAF(2),VFR(6),o[1],0,0,0), C1,4); \
    GAPB(o[0]=__builtin_amdgcn_mfma_f32_32x32x16_bf16(PAF(3),VFR(3),o[0],0,0,0), C1,8); \
    GAPB(o[1]=__builtin_amdgcn_mfma_f32_32x32x16_bf16(PAF(3),VFR(7),o[1],0,0,0), C1,12); \
    }while(0)
  int t=1;
  #undef CMASK
  #define CMASK(P0,P1,t) do{}while(0)
  for(;t+5<NT;t+=2){
    STEP(pB0,pB1,pA0,pA1,t,true,true,true);     WAIT_BAR(2); RESC(); ROT();
    STEP(pA0,pA1,pB0,pB1,t+1,true,true,true);   WAIT_BAR(2); RESC(); ROT();
  }
  #undef CMASK
  #define CMASK(P0,P1,t) do{int jb_=(t)-(NT-4); if(jb_>=0)cmask(P0,P1,jb_,qrel,hi);}while(0)
  #define ENDW(tt) do{ if((tt)+3<NT){WAIT_BAR(2);} else if((tt)+2<NT){WAIT_BAR(1);} else {WAIT_BAR(0);} }while(0)
  for(;t+1<NT;t+=2){
    STEP(pB0,pB1,pA0,pA1,t,(t+3<NT),(t+1<NT),(t+1<NT));       ENDW(t);   RESC(); ROT();
    STEP(pA0,pA1,pB0,pB1,t+1,(t+4<NT),(t+2<NT),(t+2<NT));     ENDW(t+1); RESC(); ROT();
  }
  STEP(pB0,pB1,pA0,pA1,NT-1,false,false,false); RESC();
  { float sacc=pB0[0]+pB0[1]; _Pragma("unroll") for(int r=2;r<16;++r)sacc+=pB0[r]; _Pragma("unroll") for(int r=0;r<16;++r)sacc+=pB1[r]; l_reg+=sacc;
    pw0=(u32x4){PKW(pB0,0),PKW(pB0,2),PKW(pB0,4),PKW(pB0,6)};pw1=(u32x4){PKW(pB0,8),PKW(pB0,10),PKW(pB0,12),PKW(pB0,14)};pw2=(u32x4){PKW(pB1,0),PKW(pB1,2),PKW(pB1,4),PKW(pB1,6)};pw3=(u32x4){PKW(pB1,8),PKW(pB1,10),PKW(pB1,12),PKW(pB1,14)};
    SBAR(); pv(o,vb0+sl_cur,PAF(0),PAF(1),PAF(2),PAF(3)); }
  #undef PKW
  #undef PAF
  #undef VFR
  #undef PIN
  #undef MX3
  #undef GAPA
  #undef GAPB
  #undef EX
  #undef VRD
  #undef KRD
  #undef STEP
  #undef ENDW
  const bool lead_=(wid==0)&&(r32==0)&&(hi==0);
  unsigned nxt_=0; if(ctr!=nullptr&&lead_)nxt_=__hip_atomic_fetch_add(ctr,1u,__ATOMIC_RELAXED,__HIP_MEMORY_SCOPE_AGENT);
  {auto rr=__builtin_amdgcn_permlane32_swap(__float_as_uint(l_reg),__float_as_uint(l_reg),false,false);l_reg=__uint_as_float(rr[0])+__uint_as_float(rr[1]);}
  if(hi==0)wsf[32+r32]=l_reg;asm volatile("s_waitcnt lgkmcnt(0)":::"memory");
  float rli[16];
  #pragma unroll
  for(int r=0;r<16;++r)rli[r]=__builtin_amdgcn_rcpf(wsf[32+crow(r,hi)]);
  bf16*Ow=O+(rowbase+q0+wid*QBLK)*OPITCH+OCOL+h*D;
  { bf16*stg=(bf16*)(shm+LDS_OST)+wid*2048;
    #pragma unroll
    for(int r=0;r<16;++r){const int orow=crow(r,hi);
      #pragma unroll
      for(int d0=0;d0<2;++d0)stg[orow*64+d0*32+r32]=__float2bfloat16(o[d0][r]*rli[r]);}
    asm volatile("s_waitcnt lgkmcnt(0)":::"memory");
    #pragma unroll
    for(int i=0;i<4;++i){const int row=i*8+(lane>>3),ch=lane&7; const u32x4 v=*(const u32x4*)(stg+row*64+ch*8); ATTN_STORE16(Ow+(long)row*OPITCH+ch*8,v);} }
  if(ctr!=nullptr&&lead_)*(volatile __attribute__((address_space(3))) unsigned*)((__attribute__((address_space(3))) char*)shm+LDS_BYTES)=nxt_;
  asm volatile("s_waitcnt vmcnt(0) lgkmcnt(0)\n\ts_barrier":::"memory");
  #undef BIASC
  #undef DMA_K
  #undef DMA_V
  #undef CMASK
  #undef START
  #undef RESC
  #undef ROT
}
constexpr int ATTN_LDS_BYTES=LDS_BYTES;
struct AttnTensors { const bf16* Q; const bf16* K; const bf16* V; bf16* O; const float* FB; };
struct AttnUnit { int bh; int qb; };
struct StaticOrder {
  int vcu;
  __device__ __forceinline__ explicit StaticOrder(int grid,int block):vcu((block%8)*(grid/8)+block/8){}
  __device__ __forceinline__ bool next(int i,AttnUnit&u)const{ if(i>=4)return false; u.bh=vcu>>1; const int o=(vcu&1)*2; u.qb=(i==0)?o:(i==1)?7-o:(i==2)?o+1:6-o; return true; }
  __device__ __forceinline__ void a_ready(const AttnUnit&)const{}
  __device__ __forceinline__ void done(const AttnUnit&)const{}
};
template<class Sched,int THRL=8> __device__ __forceinline__ void attn_phase(char*lds,const AttnTensors&T,const Sched&S){
  AttnUnit u;
  for(int i=0;S.next(i,u);++i){ S.a_ready(u); attn_unit<THRL>(u.bh/NHEAD,u.bh%NHEAD,u.qb,T.Q,T.K,T.V,T.O,T.FB+(size_t)u.bh*SEQ,16.f,nullptr,lds); S.done(u); }
}
template<int THRL=8> __device__ __forceinline__ void attn_phase_dyn(char*lds,const AttnTensors&T,unsigned*ctr,const float*qg,const float*kg){
  volatile __attribute__((address_space(3))) unsigned*bw=(volatile __attribute__((address_space(3))) unsigned*)((__attribute__((address_space(3))) char*)lds+LDS_BYTES);
  const int tid=threadIdx.x,lane=tid&63;
  if(tid==0)*bw=__hip_atomic_fetch_add(ctr,1u,__ATOMIC_RELAXED,__HIP_MEMORY_SCOPE_AGENT);
  __syncthreads();
  for(;;){
    const unsigned u=*bw;
    if(u>=(unsigned)(BATCH*NHEAD*NQB))break;
    const int bh=u&(BATCH*NHEAD-1),qb=NQB-1-(int)(u>>7),h=bh%NHEAD;
    float gq=fabsf(qg[h*D+lane]),gk=fabsf(kg[h*D+lane]);
    #pragma unroll
    for(int o=1;o<64;o<<=1){gq=fmaxf(gq,__shfl_xor(gq,o));gk=fmaxf(gk,__shfl_xor(gk,o));}
    const float thr=__int_as_float(__builtin_amdgcn_readfirstlane(__float_as_int(1.02f*64.f*C2*gq*gk)));
    attn_unit<THRL>(bh/NHEAD,h,qb,T.Q,T.K,T.V,T.O,T.FB+(size_t)bh*SEQ,thr,ctr,lds);
  }
  __syncthreads();
}
#undef SBAR
#undef WAIT_BAR
}
#define GAS __attribute__((address_space(1)))
#define LAS __attribute__((address_space(3)))
typedef unsigned short bf16;
typedef unsigned v4u __attribute__((ext_vector_type(4)));
typedef float f32x4 __attribute__((ext_vector_type(4)));
typedef short bf16x8 __attribute__((ext_vector_type(8)));
typedef GAS unsigned gu32;
typedef GAS unsigned long long gu64;
#define RLX_AGENT __ATOMIC_RELAXED, __HIP_MEMORY_SCOPE_AGENT
#define LDS_WAIT() asm volatile("s_waitcnt lgkmcnt(0)" ::: "memory")
#define VM_WAIT() asm volatile("s_waitcnt vmcnt(0)" ::: "memory")
__device__ __forceinline__ unsigned long long rt() { return __builtin_amdgcn_s_memrealtime(); }
__device__ __forceinline__ unsigned f2bf(float f) { unsigned u = __builtin_bit_cast(unsigned, f); return (u + 0x7fffu + ((u >> 16) & 1u)) >> 16; }
__device__ __forceinline__ unsigned pk2(float lo, float hi) { return f2bf(lo) | (f2bf(hi) << 16); }

#define XB_TMO      128
#define XB_XCNT(j)  (256  + 64 * (j))
#define XB_XSUB(j)  (1280 + 64 * (j))
#define XB_XGEN(j)  (2304 + 64 * (j))
#define XB_TOP      3328
#define XB_TOPGEN   3392
#define XCD_BAR_WORDS 3456
#define XB_SPIN_CAP (1u << 18)

__device__ __forceinline__ unsigned xb_ld(unsigned* p)              { return __hip_atomic_load(p, __ATOMIC_RELAXED, __HIP_MEMORY_SCOPE_AGENT); }
__device__ __forceinline__ unsigned xb_add(unsigned* p, unsigned v) { return __hip_atomic_fetch_add(p, v, __ATOMIC_RELAXED, __HIP_MEMORY_SCOPE_AGENT); }
__device__ __forceinline__ unsigned xb_xcc_id() { return (unsigned)__builtin_amdgcn_s_getreg((3 << 11) | 20) & 0xFu; }
#define XB_SPIN(cond, bar) do { unsigned _sp = 0; while (cond) { __builtin_amdgcn_s_sleep(1); \
    if ((++_sp & 255u) == 0u) { if (xb_ld(&(bar)[XB_TMO])) break; if (_sp > XB_SPIN_CAP) { atomicAdd(&(bar)[XB_TMO], 1u); break; } } } } while (0)

struct XcdBarrier {
    unsigned* bar; unsigned x;
    volatile LAS unsigned* st;
};

__device__ __forceinline__ XcdBarrier xcd_barrier_post(unsigned* bar, volatile LAS unsigned* st) {
    XcdBarrier b; b.bar = bar; b.x = xb_xcc_id(); b.st = st;
    if (threadIdx.x == 0) (void)xb_add(&bar[XB_XCNT(b.x)], 1u);
    return b;
}
__device__ __forceinline__ void xcd_barrier_complete(unsigned* bar, unsigned x, unsigned& nloc, unsigned& nx) {
    const unsigned G = gridDim.x * gridDim.y * gridDim.z;
    unsigned sum, cnt, mine, sp = 0u;
    for (;;) {
        sum = 0u; cnt = 0u; mine = 0u;
#pragma unroll
        for (unsigned j = 0; j < 16; ++j) { const unsigned c = xb_ld(&bar[XB_XCNT(j)]); sum += c; cnt += (c > 0u) ? 1u : 0u; mine = (j == x) ? c : mine; }
        if (sum == G) break;
        __builtin_amdgcn_s_sleep(1);
        if ((++sp & 255u) == 0u) { if (xb_ld(&bar[XB_TMO])) break; if (sp > XB_SPIN_CAP) { atomicAdd(&bar[XB_TMO], 1u); break; } }
    }
    nloc = mine > 0u ? mine : 1u; nx = cnt > 0u ? cnt : 1u;
}

__device__ __forceinline__ void xcd_barrier(const XcdBarrier& b) {
    asm volatile("s_waitcnt vmcnt(0)" ::: "memory");
    __syncthreads();
    if (threadIdx.x == 0) {
        unsigned* bar = b.bar;
        __builtin_amdgcn_s_waitcnt(0);
        unsigned nloc = b.st[0], nx = b.st[1];
        if (nloc == 0u) { xcd_barrier_complete(bar, b.x, nloc, nx); b.st[0] = nloc; b.st[1] = nx; }
        const unsigned old = xb_add(&bar[XB_XSUB(b.x)], 1u);
        const unsigned gen = old / nloc;
        if (old + 1u == (gen + 1u) * nloc) {
            __builtin_amdgcn_fence(__ATOMIC_RELEASE, "agent");
            asm volatile("s_waitcnt vmcnt(0)" ::: "memory");
            const unsigned og = xb_add(&bar[XB_TOP], 1u);
            const unsigned tg = og / nx;
            if (og + 1u == (tg + 1u) * nx) xb_add(&bar[XB_TOPGEN], 1u);
            else XB_SPIN(xb_ld(&bar[XB_TOPGEN]) == tg, bar);
            __builtin_amdgcn_fence(__ATOMIC_ACQUIRE, "agent");
            xb_add(&bar[XB_XGEN(b.x)], 1u);
            asm volatile("s_waitcnt vmcnt(0)" ::: "memory");
        } else {
            XB_SPIN(xb_ld(&bar[XB_XGEN(b.x)]) == gen, bar);
            __builtin_amdgcn_fence(__ATOMIC_ACQUIRE, "agent");
            asm volatile("s_waitcnt vmcnt(0)" ::: "memory");
        }
    }
    __syncthreads();
}

constexpr int NWAVES = 8;
constexpr int D = 1024, BATCH = 16, SEQ = 2048, T = BATCH * SEQ, NH = 8, HD = 64, INW = 2056, QW = 512;
constexpr int NEXP = 16384;
constexpr float EPS = 1e-6f, LOG2E = 1.4426950408889634f, C2 = 0.125f * LOG2E;
constexpr size_t MiB = 1u << 20;
constexpr size_t WS_CTL = 0, CTL_ZERO_BYTES = 1 * MiB;
constexpr size_t WS_W1T = 1 * MiB, WS_WOT = 5 * MiB, WS_WST = 7 * MiB, WS_LFG = 13 * MiB, WS_FB = 14 * MiB, WS_RSQ = 15 * MiB, WS_RSTD = 17 * MiB, WS_R1 = 18 * MiB;
constexpr size_t WS_XN = 32 * MiB, WS_ZP = 96 * MiB, WS_Q = 128 * MiB, WS_K = 160 * MiB, WS_V = 192 * MiB, WS_YC = 224 * MiB;
constexpr size_t WS_SC = 32 * MiB;
constexpr size_t WS_X1B = 288 * MiB, WS_UF8 = 352 * MiB, WS_VF8 = 368 * MiB, WS_SU = 384 * MiB, WS_SV = 385 * MiB, WS_IDX = 416 * MiB, WS_GATE = 424 * MiB, WS_END = 440 * MiB;
constexpr size_t WS_PA = 32 * MiB, WS_COEF = 160 * MiB;
constexpr int CW_BAR = 4096;
constexpr int RING_BYTES = 131072, LDSCTL_OFF = RING_BYTES, MISC_OFF = LDSCTL_OFF + 320, LDS_BYTES = 147456;

__device__ __forceinline__ float wave_sum(float v) {
#pragma unroll
    for (int o = 1; o < 64; o <<= 1) v += __shfl_xor(v, o);
    return v;
}
__device__ __forceinline__ float bf2f(unsigned short b) { return __uint_as_float((unsigned)b << 16); }
__device__ __forceinline__ float bflo(unsigned u) { return __uint_as_float(u << 16); }
__device__ __forceinline__ float bfhi(unsigned u) { return __uint_as_float(u & 0xffff0000u); }

namespace pg8 {
struct EpiQKV {
    static constexpr bool PERM = true, AFTER_DRAIN = false;
    bf16_t* O; const float* qg; const float* kg; const float* r1;
    __device__ __forceinline__ void operator()(const f32x4 (&acc)[2][2][4][2], const Unit& u, int wr, int wc, int fr, int fq) const {
        const int kind = u.pn >> 1; const bool norm = (kind == 1) || (kind == 2);
        bf16_t* base = O + (size_t)kind * ((size_t)T * QW) + (u.pn & 1) * 256 + 64 * wc + 8 * fq;
        const int row0 = u.pm * BM + wr * 64 + fr;
        f32x4 g[2][2]; float sc = (kind == 1) ? C2 : 1.f;
#pragma unroll
        for (int bj = 0; bj < 2; ++bj)
#pragma unroll
            for (int n = 0; n < 2; ++n) g[bj][n] = (f32x4){1.f, 1.f, 1.f, 1.f};
        if (norm) { const float* gp = (kind == 1 ? qg : kg) + ((u.pn & 1) * 4 + wc) * 64 + 8 * fq;
#pragma unroll
            for (int bj = 0; bj < 2; ++bj)
#pragma unroll
                for (int n = 0; n < 2; ++n) g[bj][n] = *(const f32x4*)(gp + 32 * bj + 4 * n); }
#pragma unroll
        for (int ai = 0; ai < 2; ++ai)
#pragma unroll
            for (int m = 0; m < 4; ++m) {
                bf16_t* rowp = base + (size_t)(row0 + ai * HALF + m * 16) * QW;
                const float rr = r1[row0 + ai * HALF + m * 16]; float r = rr;
                if (norm) { float ss = 0.f;
#pragma unroll
                    for (int bj = 0; bj < 2; ++bj)
#pragma unroll
                        for (int n = 0; n < 2; ++n) { const f32x4 v = acc[ai][bj][m][n]; ss += (v[0] * v[0] + v[1] * v[1]) + (v[2] * v[2] + v[3] * v[3]); }
                    ss += __shfl_xor(ss, 16); ss += __shfl_xor(ss, 32);
                    r = rsqrtf(ss * (rr * rr) * (1.f / 64.f) + EPS) * sc * rr; }
#pragma unroll
                for (int bj = 0; bj < 2; ++bj) { const f32x4 v0 = acc[ai][bj][m][0] * g[bj][0] * r, v1 = acc[ai][bj][m][1] * g[bj][1] * r;
                    u32x4 w; w.x = cvt_pk_bf16(v0[0], v0[1]); w.y = cvt_pk_bf16(v0[2], v0[3]); w.z = cvt_pk_bf16(v1[0], v1[1]); w.w = cvt_pk_bf16(v1[2], v1[3]);
                    *(u32x4*)(rowp + 32 * bj) = w; }
            }
    }
};
struct EpiX1 {
    static constexpr bool PERM = false, AFTER_DRAIN = false;
    const bf16_t* xb; float* out; bf16_t* x1b; float* rsq;
    __device__ __forceinline__ void operator()(const f32x4 (&acc)[2][2][4][2], const Unit& u, int wr, int wc, int fr, int fq) const {
        typedef unsigned u32x2v __attribute__((ext_vector_type(2)));
        const int row0 = u.pm * BM + wr * 64 + fr, col0 = u.pn * BM + wc * 32 + 4 * fq;
#pragma unroll
        for (int ai = 0; ai < 2; ++ai) {
            u32x2v pre[4][2][2];
#pragma unroll
            for (int m = 0; m < 4; ++m) { const size_t ro = (size_t)(row0 + ai * HALF + m * 16) * D + col0;
#pragma unroll
                for (int bj = 0; bj < 2; ++bj)
#pragma unroll
                    for (int n = 0; n < 2; ++n) pre[m][bj][n] = *(const u32x2v*)(xb + ro + bj * HALF + n * 16); }
#pragma unroll
            for (int m = 0; m < 4; ++m) { const int row = row0 + ai * HALF + m * 16; const size_t ro = (size_t)row * D + col0; float ss = 0.f;
#pragma unroll
                for (int bj = 0; bj < 2; ++bj)
#pragma unroll
                    for (int n = 0; n < 2; ++n) { const size_t off = ro + bj * HALF + n * 16; const u32x2v pw = pre[m][bj][n]; const f32x4 v = acc[ai][bj][m][n] + (f32x4){__uint_as_float(pw.x << 16), __uint_as_float(pw.x & 0xffff0000u), __uint_as_float(pw.y << 16), __uint_as_float(pw.y & 0xffff0000u)};
                        ss += (v[0] * v[0] + v[1] * v[1]) + (v[2] * v[2] + v[3] * v[3]);
                        u32x2v w; w.x = cvt_pk_bf16(v[0], v[1]); w.y = cvt_pk_bf16(v[2], v[3]); *(u32x2v*)(x1b + off) = w; }
                ss += __shfl_xor(ss, 16); ss += __shfl_xor(ss, 32);
                if (fq == 0) rsq[(size_t)row * 16 + u.pn * 4 + wc] = ss; }
        }
    }
};
struct EpiSc {
    static constexpr bool PERM = true, AFTER_DRAIN = false;
    bf16_t* C;
    __device__ __forceinline__ void operator()(const f32x4 (&acc)[2][2][4][2], const Unit& u, int wr, int wc, int fr, int fq) const {
        const int row0 = u.pm * BM + wr * 64 + fr, col0 = u.pn * BM + wc * 32 + 8 * fq;
#pragma unroll
        for (int ai = 0; ai < 2; ++ai)
#pragma unroll
            for (int m = 0; m < 4; ++m) { bf16_t* rowp = C + (size_t)(row0 + ai * HALF + m * 16) * 2048 + col0;
#pragma unroll
                for (int bj = 0; bj < 2; ++bj) { const f32x4 v0 = acc[ai][bj][m][0], v1 = acc[ai][bj][m][1];
                    u32x4 w; w.x = cvt_pk_bf16(v0[0], v0[1]); w.y = cvt_pk_bf16(v0[2], v0[3]); w.z = cvt_pk_bf16(v1[0], v1[1]); w.w = cvt_pk_bf16(v1[2], v1[3]);
                    *(u32x4*)(rowp + bj * HALF) = w; } }
    }
};
}

__device__ __forceinline__ void p0_transpose_item(const float* W, int ldw, int col0, bf16* WT, int dst0, float* scr, int kb, int lane, const float* kgain) {
    const int k0 = 64 * kb;
#pragma unroll 8
    for (int i = 0; i < 32; ++i) { const int kk = 2 * i + (lane >> 5); scr[kk * 33 + (lane & 31)] = W[(size_t)(k0 + kk) * ldw + col0 + (lane & 31)] * (kgain ? kgain[k0 + kk] : 1.f); }
    LDS_WAIT(); asm volatile("" ::: "memory");
    const int c = lane & 7;
#pragma unroll
    for (int j = 0; j < 4; ++j) { const int n = (lane >> 3) + 8 * j; const float* s = scr + (8 * c) * 33 + n;
        v4u o; o.x = pk2(s[0 * 33], s[1 * 33]); o.y = pk2(s[2 * 33], s[3 * 33]); o.z = pk2(s[4 * 33], s[5 * 33]); o.w = pk2(s[6 * 33], s[7 * 33]);
        *(v4u*)(WT + (size_t)(dst0 + n) * 1024 + k0 + 8 * c) = o; }
    LDS_WAIT(); asm volatile("" ::: "memory");
}
__device__ __forceinline__ int w1_dst_row(int n) { const int w = n & 255; return (n & ~255) + 128 * ((w >> 5) & 1) + 32 * (w >> 6) + (w & 31); }

struct Args { const float* in[14]; float* out; unsigned char* ws; };

__device__ __forceinline__ void p0_prologue(const Args& a, unsigned char* lds, int vcu, int G, int wave, int lane, int tid, int mask) {
    const float* w_in = a.in[2]; const float* w_pool = a.in[6]; const float* pscale = a.in[7]; const float* w_out = a.in[8]; const float* n2g = a.in[9];
    const float* w_query = a.in[10]; const float* sk = a.in[11];
    bf16* W1T = (bf16*)(a.ws + WS_W1T); bf16* WOT = (bf16*)(a.ws + WS_WOT); bf16* WST = (bf16*)(a.ws + WS_WST);
    const int NGW = G * NWAVES;
    const int gwi = wave * G + vcu;
    if (mask & 1) {
        const int grp = vcu >> 4, kb = vcu & 15, h = grp >> 1, half = grp & 1, k0 = kb * 64;
        float* skT = (float*)lds;
        float* wqt = (float*)(lds + 67584);
        for (int i = tid; i < 128 * 128; i += NWAVES * 64) skT[(i & 127) * 132 + (i >> 7)] = sk[(size_t)half * 16384 + i];
        for (int i = tid; i < 64 * 128; i += NWAVES * 64) { const int r = i >> 7, c = i & 127; wqt[r * 129 + c] = w_query[(size_t)(k0 + r) * 2048 + h * 256 + half * 128 + c] * n2g[k0 + r]; }
        __syncthreads();
        const int kq = tid & 63; float acc[16];
#pragma unroll
        for (int q = 0; q < 16; ++q) acc[q] = 0.f;
#pragma unroll 4
        for (int c = 0; c < 128; ++c) { const float w = wqt[kq * 129 + c];
#pragma unroll
            for (int q = 0; q < 4; ++q) { const f32x4 s4 = *(const f32x4*)(skT + c * 132 + wave * 16 + 4 * q); acc[4 * q] += w * s4.x; acc[4 * q + 1] += w * s4.y; acc[4 * q + 2] += w * s4.z; acc[4 * q + 3] += w * s4.w; } }
#pragma unroll
        for (int q = 0; q < 16; ++q) WST[(size_t)(grp * 128 + wave * 16 + q) * 1024 + k0 + kq] = (bf16)f2bf(acc[q]);
        __syncthreads();
    }
    { float* wf = (float*)lds;
      for (int i = tid; i < 1024 * 8; i += NWAVES * 64) wf[(i & 7) * 1024 + (i >> 3)] = w_in[(size_t)(i >> 3) * INW + 2048 + (i & 7)]; }
    __syncthreads();
    float* scr = (float*)(lds + 32768 + wave * 8704);
    if (mask & 1) {
    for (int it = (gwi + 2 * G) % NGW; it < 768 + 512; it += NGW) {
        if (it < 768) { const int nb = it >> 4, kb = it & 15, n0 = 512 + 32 * nb; p0_transpose_item(w_in, INW, n0, W1T, w1_dst_row(n0), scr, kb, lane, a.in[1]); }
        else { const int r = it - 768, nb = r >> 4, kb = r & 15; p0_transpose_item(w_out, D, 32 * nb, WOT, 32 * nb, scr, kb, lane, nullptr); }
    }
    typedef const __attribute__((address_space(4))) float* cfp;
    for (int it = (gwi + 6 * G) % NGW; it < 1024; it += NGW) {
        const int kb = __builtin_amdgcn_readfirstlane(it >> 3), g = __builtin_amdgcn_readfirstlane((it >> 1) & 3), d = (it & 1) * 64 + lane, k0 = 8 * kb; float acc[8];
#pragma unroll
        for (int q = 0; q < 8; ++q) acc[q] = 0.f;
#pragma unroll 1
        for (int c0 = 0; c0 < 128; c0 += 8) { float wp[8];
#pragma unroll
            for (int c = 0; c < 8; ++c) wp[c] = w_pool[((size_t)g * 128 + c0 + c) * 128 + d];
#pragma unroll
            for (int q = 0; q < 8; ++q) { cfp wr = (cfp)(w_in + (size_t)(k0 + q) * INW + g * 128 + c0);
#pragma unroll
                for (int c = 0; c < 8; ++c) acc[q] += wr[c] * wp[c]; } }
        const float s = pscale[g * 128 + d]; { const float* g1k = a.in[1] + k0;
#pragma unroll
            for (int q = 0; q < 8; ++q) acc[q] *= s * g1k[q]; }
        v4u o; o.x = pk2(acc[0], acc[1]); o.y = pk2(acc[2], acc[3]); o.z = pk2(acc[4], acc[5]); o.w = pk2(acc[6], acc[7]);
        *(v4u*)(W1T + (size_t)w1_dst_row(g * 128 + d) * 1024 + k0) = o;
    }
    }
    if (mask & 4) { const float* wf = (const float*)lds;
      const float* x = a.in[0]; const float* g1 = a.in[1]; const float* bfg = a.in[3]; bf16* XN = (bf16*)(a.ws + WS_XN); float* LFG = (float*)(a.ws + WS_LFG);
      const int per = T / G;
      for (int q = 2 * wave; q < per; q += 2 * NWAVES) {
          f32x4 v[2][4];
#pragma unroll
          for (int u = 0; u < 2; ++u) { const f32x4* xr = (const f32x4*)(x + (size_t)(vcu * per + q + u) * D) + lane;
#pragma unroll
              for (int j = 0; j < 4; ++j) v[u][j] = __builtin_nontemporal_load(xr + 64 * j); }
#pragma unroll
          for (int u = 0; u < 2; ++u) { const int m = vcu * per + q + u; float s = 0.f;
#pragma unroll
              for (int j = 0; j < 4; ++j) s += (v[u][j].x * v[u][j].x + v[u][j].y * v[u][j].y) + (v[u][j].z * v[u][j].z + v[u][j].w * v[u][j].w);
              const float r = rsqrtf(wave_sum(s) * (1.f / D) + EPS); float f[8]; if (lane == 0) ((float*)(a.ws + WS_R1))[m] = r;
#pragma unroll
              for (int h = 0; h < 8; ++h) f[h] = 0.f;
              unsigned long long* o8 = (unsigned long long*)(XN + (size_t)m * D) + lane;
#pragma unroll
              for (int j = 0; j < 4; ++j) { const f32x4 gg = ((const f32x4*)g1)[lane + 64 * j]; const f32x4 hv = v[u][j] * r * gg;
                  o8[64 * j] = (unsigned long long)pk2(v[u][j].x, v[u][j].y) | ((unsigned long long)pk2(v[u][j].z, v[u][j].w) << 32);
#pragma unroll
                  for (int h = 0; h < 8; ++h) { const f32x4 w4 = *(const f32x4*)(wf + h * 1024 + 4 * (lane + 64 * j)); f[h] += (hv.x * w4.x + hv.y * w4.y) + (hv.z * w4.z + hv.w * w4.w); } }
#pragma unroll
              for (int h = 0; h < 8; ++h) f[h] = wave_sum(f[h]);
              float fs = f[0];
#pragma unroll
              for (int h = 1; h < 8; ++h) fs = (lane == h) ? f[h] : fs;
              if (lane < 8) { const float z = fs + bfg[lane]; LFG[(size_t)m * 8 + lane] = fminf(z, 0.f) - log1pf(expf(-fabsf(z))); } } }
    }
}

__device__ __forceinline__ void p1_cumsum(const Args& a, unsigned char* lds, int wave, int lane, int tid) {
    if (blockIdx.x < BATCH * NH) {
        const int bh = blockIdx.x, b = bh >> 3, h = bh & 7; const float* LFG = (const float*)(a.ws + WS_LFG); float* FB = (float*)(a.ws + WS_FB);
        float v[4];
#pragma unroll
        for (int i = 0; i < 4; ++i) v[i] = LFG[((size_t)b * SEQ + tid * 4 + i) * 8 + h];
        v[1] += v[0]; v[2] += v[1]; v[3] += v[2];
        const float tot = v[3]; float sc = tot;
#pragma unroll
        for (int o = 1; o < 64; o <<= 1) { const float n = __shfl_up(sc, o); if (lane >= o) sc += n; }
        float* wt = (float*)lds; if (lane == 63) wt[wave] = sc; __syncthreads();
        float off = 0.f; for (int w = 0; w < wave; ++w) off += wt[w];
        const float excl = off + sc - tot;
#pragma unroll
        for (int i = 0; i < 4; ++i) FB[(size_t)bh * SEQ + tid * 4 + i] = -(excl + v[i]) * LOG2E;
        __syncthreads();
    }
}

template <int W> __device__ __forceinline__ void pool_item(const bf16* ZP, bf16* YC, int t, int c8) {
    const int s = t & (SEQ - 1); v4u v[W];
#pragma unroll
    for (int k = 0; k < W; ++k) { const bool in = s - k >= 0; const v4u x = *(const v4u*)(ZP + (size_t)(in ? t - k : t) * QW + c8); v[k] = in ? x : (v4u){0u, 0u, 0u, 0u}; }
    float acc[8];
#pragma unroll
    for (int i = 0; i < 8; ++i) acc[i] = 0.f;
#pragma unroll
    for (int k = W - 1; k >= 0; --k) { acc[0] += bflo(v[k].x); acc[1] += bfhi(v[k].x); acc[2] += bflo(v[k].y); acc[3] += bfhi(v[k].y); acc[4] += bflo(v[k].z); acc[5] += bfhi(v[k].z); acc[6] += bflo(v[k].w); acc[7] += bfhi(v[k].w); }
    const float ic = 1.f / (float)(s + 1 < W ? s + 1 : W); const v4u cur = v[0];
    v4u o; o.x = pk2(acc[0] * ic - bflo(cur.x), acc[1] * ic - bfhi(cur.x)); o.y = pk2(acc[2] * ic - bflo(cur.y), acc[3] * ic - bfhi(cur.y));
    o.z = pk2(acc[4] * ic - bflo(cur.z), acc[5] * ic - bfhi(cur.z)); o.w = pk2(acc[6] * ic - bflo(cur.w), acc[7] * ic - bfhi(cur.w));
    *(v4u*)(YC + (size_t)t * D + c8) = o;
}
__device__ __forceinline__ void p2_pool(const Args& a, int gtid, int NGT) {
    const bf16* ZP = (const bf16*)(a.ws + WS_ZP); bf16* YC = (bf16*)(a.ws + WS_YC);
    const int gw = __builtin_amdgcn_readfirstlane(gtid >> 6), NGW = NGT >> 6, lane = gtid & 63;
    for (int wi = gw; wi < T; wi += NGW) {
        const int g = wi & 3, t = 4 * (wi >> 2) + (lane >> 4), c8 = 128 * g + 8 * (lane & 15);
        if (g == 0) pool_item<2>(ZP, YC, t, c8); else if (g == 1) pool_item<4>(ZP, YC, t, c8); else if (g == 2) pool_item<8>(ZP, YC, t, c8); else pool_item<16>(ZP, YC, t, c8);
    }
}

__device__ __forceinline__ float kmax(float a, float b) { float r; asm("v_max_f32_e32 %0, %1, %2" : "=v"(r) : "v"(a), "v"(b)); return r; }
__device__ __forceinline__ float kmin(float a, float b) { float r; asm("v_min_f32_e32 %0, %1, %2" : "=v"(r) : "v"(a), "v"(b)); return r; }
#define RT_CE(a, b) do { const float h_ = kmax(a, b), l_ = kmin(a, b); a = h_; b = l_; } while (0)
template <int N> __device__ __forceinline__ void rt_sort_desc(float (&x)[N]) {
#pragma unroll
    for (int k = 2; k <= N; k <<= 1)
#pragma unroll
        for (int j = k >> 1; j > 0; j >>= 1)
#pragma unroll
            for (int i = 0; i < N; ++i) { const int l = i ^ j; if (l > i) { if ((i & k) == 0) RT_CE(x[i], x[l]); else RT_CE(x[l], x[i]); } }
}
__device__ __forceinline__ void rt_merge16(float (&A)[16], const float (&B)[16]) {
#pragma unroll
    for (int i = 0; i < 16; ++i) A[i] = kmax(A[i], B[15 - i]);
#pragma unroll
    for (int j = 8; j > 0; j >>= 1)
#pragma unroll
        for (int i = 0; i < 16; ++i) { const int l = i ^ j; if (l > i) RT_CE(A[i], A[l]); }
}
__device__ __forceinline__ float rt_key(float v, unsigned mask, unsigned code) { return __uint_as_float((__float_as_uint(v) & mask) | code); }

__device__ __forceinline__ unsigned q8_pack4(float x0, float x1, float x2, float x3, float inv) {
    const unsigned y0 = __builtin_bit_cast(unsigned, __builtin_fmaf(x0, inv, 12582912.f)), y1 = __builtin_bit_cast(unsigned, __builtin_fmaf(x1, inv, 12582912.f));
    const unsigned y2 = __builtin_bit_cast(unsigned, __builtin_fmaf(x2, inv, 12582912.f)), y3 = __builtin_bit_cast(unsigned, __builtin_fmaf(x3, inv, 12582912.f));
    return (y0 & 0xffu) | ((y1 & 0xffu) << 8) | ((y2 & 0xffu) << 16) | (y3 << 24);
}
__device__ __forceinline__ void tbl_load(const Args& a, int r, int lane, f32x4 (&v)[4]) {
    const bool isv = r >= NEXP; const int e = isv ? r - NEXP : r; const float* src = (isv ? a.in[13] : a.in[12]) + (size_t)e * D + 16 * lane;
#pragma unroll
    for (int j = 0; j < 4; ++j) v[j] = __builtin_nontemporal_load((const f32x4*)(src + 4 * j));
}
__device__ __forceinline__ void tbl_store(const Args& a, int r, int lane, f32x4 (&v)[4]) {
    const bool isv = r >= NEXP; const int e = isv ? r - NEXP : r; const float* n2g = a.in[9]; float am = 0.f;
#pragma unroll
    for (int j = 0; j < 4; ++j) { if (!isv) v[j] = v[j] * *(const f32x4*)(n2g + 16 * lane + 4 * j);
        am = fmaxf(am, fmaxf(fmaxf(fabsf(v[j].x), fabsf(v[j].y)), fmaxf(fabsf(v[j].z), fabsf(v[j].w)))); }
#pragma unroll
    for (int o = 1; o < 64; o <<= 1) am = fmaxf(am, __shfl_xor(am, o));
    const float sc = am > 0.f ? am * (isv ? 1.f / 448.f : 1.f / 127.f) : 1.f, inv = 1.f / sc; v4u o;
    if (isv) {
#pragma unroll
        for (int j = 0; j < 4; ++j) { int w = 0; w = __builtin_amdgcn_cvt_pk_fp8_f32(v[j].x * inv, v[j].y * inv, w, false); w = __builtin_amdgcn_cvt_pk_fp8_f32(v[j].z * inv, v[j].w * inv, w, true); o[j] = (unsigned)w; }
    } else {
#pragma unroll
        for (int j = 0; j < 4; ++j) o[j] = q8_pack4(v[j].x, v[j].y, v[j].z, v[j].w, inv);
    }
    *(v4u*)((isv ? a.ws + WS_VF8 : a.ws + WS_UF8) + (size_t)e * D + 16 * lane) = o;
    if (lane == 0) ((float*)(a.ws + WS_SU))[2 * e + (isv ? 1 : 0)] = sc;
}
__device__ __forceinline__ void p5_route(const Args& a, unsigned char* lds, int gw, int NGW, int wave, int lane) {
    const bf16* SC = (const bf16*)(a.ws + WS_SC); const float* RSQ = (const float*)(a.ws + WS_RSQ); float* RSTD = (float*)(a.ws + WS_RSTD);
    unsigned short* IDX = (unsigned short*)(a.ws + WS_IDX); float* GATE = (float*)(a.ws + WS_GATE);
    float* tile = (float*)(lds + wave * 12288);
    unsigned char* ibuf = lds + wave * 12288 + 8448 + lane * 32;
    int trow = gw * ((2 * NEXP) / NGW);
    const int trow_end = trow + (2 * NEXP) / NGW;
    for (int task = gw; task < (T / 64) * 8; task += NGW) {
        const int tb = task >> 3, h = task & 7, t0 = tb * 64, t = t0 + lane;
        float rs = 0.f;
        { const f32x4* rp = (const f32x4*)(RSQ + (size_t)t * 16);
#pragma unroll
          for (int i = 0; i < 4; ++i) { const f32x4 v = rp[i]; rs += (v.x + v.y) + (v.z + v.w); } }
        const float rstd = rsqrtf(rs * (1.f / D) + EPS);
        if (h == 0) RSTD[t] = rstd;
        float L1[16], L2[16];
#pragma unroll
        for (int half = 0; half < 2; ++half) {
            float L[16];
#pragma unroll
            for (int q = 0; q < 4; ++q) {
                f32x4 tv[4]; const bool tdo = trow < trow_end; if (tdo) tbl_load(a, trow, lane, tv);
                const bf16* src = SC + (size_t)t0 * 2048 + h * 256 + half * 128 + q * 32 + 8 * (lane & 3);
#pragma unroll
                for (int i = 0; i < 4; ++i) { const int row = (lane >> 2) + 16 * i; const v4u v = *(const v4u*)(src + (size_t)row * 2048);
                    float* d = tile + row * 33 + 8 * (lane & 3); d[0] = bflo(v.x); d[1] = bfhi(v.x); d[2] = bflo(v.y); d[3] = bfhi(v.y); d[4] = bflo(v.z); d[5] = bfhi(v.z); d[6] = bflo(v.w); d[7] = bfhi(v.w); }
                LDS_WAIT(); asm volatile("" ::: "memory");
                float x0[16], x1[16];
#pragma unroll
                for (int c = 0; c < 16; ++c) { x0[c] = rt_key(tile[lane * 33 + c], ~127u, (unsigned)(127 - (q * 32 + c))); x1[c] = rt_key(tile[lane * 33 + 16 + c], ~127u, (unsigned)(127 - (q * 32 + 16 + c))); }
                LDS_WAIT(); asm volatile("" ::: "memory");
                rt_sort_desc<16>(x0); rt_sort_desc<16>(x1); rt_merge16(x0, x1);
                if (q == 0) {
#pragma unroll
                    for (int c = 0; c < 16; ++c) L[c] = x0[c];
                } else rt_merge16(L, x0);
                if (tdo) { tbl_store(a, trow, lane, tv); ++trow; }
            }
#pragma unroll
            for (int c = 0; c < 16; ++c) { if (half == 0) L1[c] = L[c]; else L2[c] = L[c]; }
        }
        { unsigned w[8];
#pragma unroll
          for (int c = 0; c < 4; ++c) { w[c] = (__float_as_uint(L1[4 * c]) & 127u) | ((__float_as_uint(L1[4 * c + 1]) & 127u) << 8) | ((__float_as_uint(L1[4 * c + 2]) & 127u) << 16) | ((__float_as_uint(L1[4 * c + 3]) & 127u) << 24);
              w[4 + c] = (__float_as_uint(L2[4 * c]) & 127u) | ((__float_as_uint(L2[4 * c + 1]) & 127u) << 8) | ((__float_as_uint(L2[4 * c + 2]) & 127u) << 16) | ((__float_as_uint(L2[4 * c + 3]) & 127u) << 24); }
          *(v4u*)ibuf = (v4u){w[0] ^ 0x7f7f7f7fu, w[1] ^ 0x7f7f7f7fu, w[2] ^ 0x7f7f7f7fu, w[3] ^ 0x7f7f7f7fu}; *(v4u*)(ibuf + 16) = (v4u){w[4] ^ 0x7f7f7f7fu, w[5] ^ 0x7f7f7f7fu, w[6] ^ 0x7f7f7f7fu, w[7] ^ 0x7f7f7f7fu}; }
        float C[16];
#pragma unroll
        for (int b = 0; b < 16; ++b) C[b] = rt_key(L1[0] + L2[b], ~255u, (unsigned)(255 - b));
#pragma unroll
        for (int aa = 1; aa < 16; ++aa)
#pragma unroll
            for (int b = 0; b < 16; ++b) if ((aa + 1) * (b + 1) <= 16) {
                float x = rt_key(L1[aa] + L2[b], ~255u, (unsigned)(255 - (16 * aa + b)));
#pragma unroll
                for (int i = (aa + 1) * (b + 1) - 1; i < 16; ++i) RT_CE(C[i], x);
            }
        LDS_WAIT(); asm volatile("" ::: "memory");
        float g[16], sum = 0.f; unsigned ex[16];
#pragma unroll
        for (int i = 0; i < 16; ++i) { const unsigned code = 255u - (__float_as_uint(C[i]) & 255u); ex[i] = (unsigned)ibuf[code >> 4] * 128u + (unsigned)ibuf[16 + (code & 15u)];
            g[i] = __builtin_amdgcn_exp2f((C[i] - C[0]) * (rstd * LOG2E)); sum += g[i]; }
        const float inv = 1.f / sum;
        unsigned short* ip = IDX + (size_t)t * 128 + h * 16; float* gp = GATE + (size_t)t * 128 + h * 16;
        *(v4u*)ip = (v4u){ex[0] | (ex[1] << 16), ex[2] | (ex[3] << 16), ex[4] | (ex[5] << 16), ex[6] | (ex[7] << 16)};
        *(v4u*)(ip + 8) = (v4u){ex[8] | (ex[9] << 16), ex[10] | (ex[11] << 16), ex[12] | (ex[13] << 16), ex[14] | (ex[15] << 16)};
#pragma unroll
        for (int i = 0; i < 4; ++i) *(f32x4*)(gp + 4 * i) = (f32x4){g[4 * i] * inv, g[4 * i + 1] * inv, g[4 * i + 2] * inv, g[4 * i + 3] * inv};
        LDS_WAIT(); asm volatile("" ::: "memory");
    }
    for (; trow < trow_end; ++trow) { f32x4 tv[4]; tbl_load(a, trow, lane, tv); tbl_store(a, trow, lane, tv); }
}

typedef float f32x2 __attribute__((ext_vector_type(2)));
__device__ __forceinline__ float dpp_sum8(float s) {
    s += __builtin_bit_cast(float, __builtin_amdgcn_update_dpp(0, __builtin_bit_cast(int, s), 0xB1, 0xF, 0xF, true));
    s += __builtin_bit_cast(float, __builtin_amdgcn_update_dpp(0, __builtin_bit_cast(int, s), 0x4E, 0xF, 0xF, true));
    s += __builtin_bit_cast(float, __builtin_amdgcn_update_dpp(0, __builtin_bit_cast(int, s), 0x141, 0xF, 0xF, true));
    return s;
}
typedef __bf16 bf16x2_t __attribute__((ext_vector_type(2)));
typedef _Float16 f16x2_t __attribute__((ext_vector_type(2)));
#ifdef PROBE_U2
#define EX_REPU _Pragma("unroll 1") for (int ru_ = 0; ru_ < 2; ++ru_)
#else
#define EX_REPU
#endif
#ifdef PROBE_V2
#define EX_REPV _Pragma("unroll 1") for (int rv_ = 0; rv_ < 2; ++rv_)
#else
#define EX_REPV
#endif
#define EX_IDX(iw, i) (((i) & 1) ? ((iw)[(i) >> 1] >> 16) : ((iw)[(i) >> 1] & 0xffffu))
#define EX_GATHER(r, iw, tbase, loff) do { _Pragma("unroll") for (int i_ = 0; i_ < 8; ++i_) r[i_] = *(const v4u*)((tbase) + (unsigned)((EX_IDX(iw, i_) << 10) + (loff))); } while (0)
__device__ __forceinline__ void p6_experts(const Args& a, unsigned char* lds, int bx, int vcu, int wave, int lane, int tid) {
    const bf16* X1B = (const bf16*)(a.ws + WS_X1B); const unsigned char* UF8 = a.ws + WS_UF8; const unsigned char* VF8 = a.ws + WS_VF8;
    const unsigned short* IDX = (const unsigned short*)(a.ws + WS_IDX); const float* GATE = (const float*)(a.ws + WS_GATE);
    const float* RSTD = (const float*)(a.ws + WS_RSTD); const f32x2* SUV = (const f32x2*)(a.ws + WS_SU);
    float* dots = (float*)lds;
    unsigned* idl = (unsigned*)(lds + 65536);
    const int xg = bx & 7, t0 = vcu * 128, l8 = lane & 7;
#pragma unroll
    for (int k = 0; k < 2; ++k) { const int tl = wave * 8 + (lane >> 3) + 64 * k; const v4u* src = (const v4u*)(IDX + (size_t)(t0 + tl) * 128); v4u* dst = (v4u*)(idl + tl * 128); v4u* dz = (v4u*)(dots + tl * 128);
#pragma unroll
        for (int h = 0; h < 2; ++h) { const v4u w = src[8 * h + l8];
            const unsigned w0 = w.x, w1 = w.y, w2 = w.z, w3 = w.w;
            dst[2 * (8 * h + l8)]     = (v4u){(w0 & 0xffffu) << 10, (w0 >> 16) << 10, (w1 & 0xffffu) << 10, (w1 >> 16) << 10};
            dst[2 * (8 * h + l8) + 1] = (v4u){(w2 & 0xffffu) << 10, (w2 >> 16) << 10, (w3 & 0xffffu) << 10, (w3 >> 16) << 10}; }
#pragma unroll
        for (int h = 0; h < 4; ++h) dz[8 * h + l8] = (v4u){0u, 0u, 0u, 0u}; }
    LDS_WAIT(); asm volatile("" ::: "memory");
#define EX_IDS(dst, p) do { dst[0] = *(const v4u*)(p); dst[1] = *(const v4u*)((p) + 4); } while (0)
#define EX_GATHER2(r, iw, tbase, loff) do { _Pragma("unroll") for (int i_ = 0; i_ < 8; ++i_) r[i_] = *(const v4u*)((tbase) + (unsigned)(iw[i_ >> 2][i_ & 3] + (loff))); } while (0)
    EX_REPU {
        int tl = wave * 8 + (lane >> 3);
        unsigned ub = 128u * (unsigned)(xg & 7) + 16u * (unsigned)l8;
        const unsigned* ip = idl + tl * 128;
        int x[4], xn[4]; float xs = 0.f, xsn = 0.f;
#define UD_LOADX(xv, xsv, tl_, j_) do { const bf16* xp_ = X1B + (size_t)(t0 + (tl_)) * D + 128 * (j_) + 16 * l8; const v4u w0_ = *(const v4u*)xp_, w1_ = *(const v4u*)(xp_ + 8); \
            const unsigned s0_ = w0_.x, s1_ = w0_.y, s2_ = w0_.z, s3_ = w0_.w, s4_ = w1_.x, s5_ = w1_.y, s6_ = w1_.z, s7_ = w1_.w; \
            float am_ = fmaxf(fmaxf(fmaxf(fabsf(bflo(s0_)), fabsf(bfhi(s0_))), fmaxf(fabsf(bflo(s1_)), fabsf(bfhi(s1_)))), fmaxf(fmaxf(fabsf(bflo(s2_)), fabsf(bfhi(s2_))), fmaxf(fabsf(bflo(s3_)), fabsf(bfhi(s3_))))); \
            am_ = fmaxf(am_, fmaxf(fmaxf(fmaxf(fabsf(bflo(s4_)), fabsf(bfhi(s4_))), fmaxf(fabsf(bflo(s5_)), fabsf(bfhi(s5_)))), fmaxf(fmaxf(fabsf(bflo(s6_)), fabsf(bfhi(s6_))), fmaxf(fabsf(bflo(s7_)), fabsf(bfhi(s7_)))))); \
            am_ = fmaxf(am_, __builtin_bit_cast(float, __builtin_amdgcn_update_dpp(0, __builtin_bit_cast(int, am_), 0xB1, 0xF, 0xF, true))); \
            am_ = fmaxf(am_, __builtin_bit_cast(float, __builtin_amdgcn_update_dpp(0, __builtin_bit_cast(int, am_), 0x4E, 0xF, 0xF, true))); \
            am_ = fmaxf(am_, __builtin_bit_cast(float, __builtin_amdgcn_update_dpp(0, __builtin_bit_cast(int, am_), 0x141, 0xF, 0xF, true))); \
            am_ = fmaxf(am_, 1e-20f); const float qi_ = 127.f / am_; xsv = am_ * (1.f / 127.f); \
            xv[0] = (int)q8_pack4(bflo(s0_), bfhi(s0_), bflo(s1_), bfhi(s1_), qi_); xv[1] = (int)q8_pack4(bflo(s2_), bfhi(s2_), bflo(s3_), bfhi(s3_), qi_); \
            xv[2] = (int)q8_pack4(bflo(s4_), bfhi(s4_), bflo(s5_), bfhi(s5_), qi_); xv[3] = (int)q8_pack4(bflo(s6_), bfhi(s6_), bflo(s7_), bfhi(s7_), qi_); } while (0)
#define UD_CONSUME(r, pbase) do { int res_[8]; const float old_ = pa[(pbase) + l8];     \
            _Pragma("unroll") for (int i_ = 0; i_ < 8; ++i_) { int acc_ = 0; \
            _Pragma("unroll") for (int c_ = 0; c_ < 4; ++c_) acc_ = __builtin_amdgcn_sdot4((int)r[i_][c_], x[c_], acc_, false); \
            res_[i_] = acc_; } \
              \
            int va_[4], vb_[2]; \
            _Pragma("unroll") for (int k_ = 0; k_ < 4; ++k_) { const int kp_ = hb4_ ? res_[k_ + 4] : res_[k_], sd_ = hb4_ ? res_[k_] : res_[k_ + 4]; va_[k_] = kp_ + __builtin_amdgcn_update_dpp(0, sd_, 0x141, 0xF, 0xF, true); } \
            _Pragma("unroll") for (int k_ = 0; k_ < 2; ++k_) { const int kp_ = hb2_ ? va_[k_ + 2] : va_[k_], sd_ = hb2_ ? va_[k_] : va_[k_ + 2]; vb_[k_] = kp_ + __builtin_amdgcn_update_dpp(0, sd_, 0x4E, 0xF, 0xF, true); } \
            const int kp1_ = hb1_ ? vb_[1] : vb_[0], sd1_ = hb1_ ? vb_[0] : vb_[1]; \
            const float mine_ = (float)(kp1_ + __builtin_amdgcn_update_dpp(0, sd1_, 0xB1, 0xF, 0xF, true)) * xs; \
              \
            pa[(pbase) + l8] = old_ + mine_; } while (0)
        const bool hb4_ = (l8 & 4) != 0, hb2_ = (l8 & 2) != 0, hb1_ = (l8 & 1) != 0;
        UD_LOADX(x, xs, tl, xg & 7);
        v4u iA[2], iB[2], rA[8], rB[8]; EX_IDS(iA, ip); EX_IDS(iB, ip + 8);
        EX_GATHER2(rA, iA, UF8, ub);
        for (int g = 0; g < 16; ++g) {
            const int gn = g < 15 ? g + 1 : 15, tln = wave * 8 + (lane >> 3) + 64 * (gn & 1), jn = ((gn >> 1) + xg) & 7;
            const unsigned ubn = 128u * (unsigned)jn + 16u * (unsigned)l8; const unsigned* ipn = idl + tln * 128;
            float* pa = dots + tl * 128;
            for (int p0 = 0; p0 < 128; p0 += 16) {
                const bool last = p0 == 112;
                const unsigned* ipx = last ? ipn : ip + p0 + 16;
                v4u iA2[2], iB2[2]; EX_IDS(iA2, ipx); EX_IDS(iB2, ipx + 8);
                if (last) UD_LOADX(xn, xsn, tln, jn);
                EX_GATHER2(rB, iB, UF8, ub); __builtin_amdgcn_sched_barrier(0);
                UD_CONSUME(rA, p0); __builtin_amdgcn_sched_barrier(0);
                { const unsigned ubx = last ? ubn : ub; EX_GATHER2(rA, iA2, UF8, ubx); } __builtin_amdgcn_sched_barrier(0);
                UD_CONSUME(rB, p0 + 8); __builtin_amdgcn_sched_barrier(0);
                iB[0] = iB2[0]; iB[1] = iB2[1];
            }
#pragma unroll
            for (int c = 0; c < 4; ++c) x[c] = xn[c];
            xs = xsn; tl = tln; ub = ubn; ip = ipn;
        }
#undef UD_CONSUME
#undef UD_LOADX
    }
    LDS_WAIT(); asm volatile("" ::: "memory");
#pragma unroll 1
    for (int k = 0; k < 2; ++k) { const int i8 = lane >> 3, tl = wave * 8 + i8 + 64 * k, base = tl * 128; const float r = RSTD[t0 + tl];
        unsigned char* blk = lds + (size_t)(64 * k + 8 * wave) * 512;
        float cf_[16]; int e_[16];
#pragma unroll
        for (int u = 0; u < 16; ++u) { cf_[u] = dots[base + l8 + 8 * u]; e_[u] = (int)(idl[base + l8 + 8 * u] >> 10); }
        LDS_WAIT(); asm volatile("" ::: "memory");
        float am = 0.f;
#pragma unroll
        for (int h = 0; h < 2; ++h) { float su_[8], sv_[8], g_[8];
#pragma unroll
            for (int u = 0; u < 8; ++u) { const int sl = l8 + 8 * (8 * h + u), e = e_[8 * h + u]; const f32x2 uv = SUV[e]; su_[u] = uv.x; sv_[u] = uv.y; g_[u] = GATE[(size_t)(t0 + tl) * 128 + sl]; }
#pragma unroll
            for (int u = 0; u < 8; ++u) { const float sdot = cf_[8 * h + u] * r * su_[u]; const float cf = 0.5f * sdot * (1.f + erff(sdot * 0.70710678118654752f)) * g_[u] * sv_[u];
                cf_[8 * h + u] = cf; am = fmaxf(am, fabsf(cf)); } }
        am = fmaxf(am, __builtin_bit_cast(float, __builtin_amdgcn_update_dpp(0, __builtin_bit_cast(int, am), 0xB1, 0xF, 0xF, true)));
        am = fmaxf(am, __builtin_bit_cast(float, __builtin_amdgcn_update_dpp(0, __builtin_bit_cast(int, am), 0x4E, 0xF, 0xF, true)));
        am = fmaxf(am, __builtin_bit_cast(float, __builtin_amdgcn_update_dpp(0, __builtin_bit_cast(int, am), 0x141, 0xF, 0xF, true)));
        const float qs = am > 0.f ? 448.f / am : 0.f;
        unsigned short* idt = (unsigned short*)(blk + 1024);
#pragma unroll
        for (int u = 0; u < 16; u += 2) { const int w = __builtin_amdgcn_cvt_pk_fp8_f32(cf_[u] * qs, cf_[u + 1] * qs, 0, false);
            const int x0 = (i8 * 4 + (l8 & 3)) * 32 + 2 * u + (l8 >> 2), x1 = x0 + 2;
            blk[x0] = (unsigned char)(w & 0xff); blk[x1] = (unsigned char)((w >> 8) & 0xff); idt[x0] = (unsigned short)e_[u]; idt[x1] = (unsigned short)e_[u + 1]; }
        if (l8 == 0) ((float*)(blk + 3072))[i8] = am * (1.f / 448.f);
    }
    LDS_WAIT(); asm volatile("" ::: "memory");
    EX_REPV {
        const int gq = lane >> 4, sp = (lane >> 3) & 1, ch = lane & 7;
        const unsigned mklo = ch < 4 ? (0xffu << (8 * ch)) : 0u, mkhi = ch >= 4 ? (0xffu << (8 * (ch - 4))) : 0u;
        const bool vld = (gq >> 1) == sp;
        f32x4 acc0 = {0.f, 0.f, 0.f, 0.f}, acc1 = {0.f, 0.f, 0.f, 0.f};
#define VP_ROW(p_) (((2 * ((p_) >> 1) + sp) * 4 + gq) * 32 + 16 * ((p_) & 1))
#define VM_STEP8(r, cl_, ch_) do { _Pragma("unroll") for (int i_ = 0; i_ < 8; ++i_) { const unsigned cwd_ = i_ < 4 ? (cl_) : (ch_); \
            const unsigned rep_ = __builtin_amdgcn_perm(cwd_, cwd_, 0x01010101u * (unsigned)(i_ & 3));       \
            const long am_ = (long)(((unsigned long)(rep_ & mkhi) << 32) | (unsigned long)(rep_ & mklo)); \
            const long b0_ = (long)(((unsigned long)r[i_].y << 32) | (unsigned long)r[i_].x), b1_ = (long)(((unsigned long)r[i_].w << 32) | (unsigned long)r[i_].z); \
            acc0 = __builtin_amdgcn_mfma_f32_16x16x32_fp8_fp8(am_, b0_, acc0, 0, 0, 0); acc1 = __builtin_amdgcn_mfma_f32_16x16x32_fp8_fp8(am_, b1_, acc1, 0, 0, 0); } } while (0)
        const unsigned char* blk = lds + (size_t)(8 * wave) * 512;
        int j = xg & 7;
        unsigned vb = 128u * (unsigned)j + 16u * (unsigned)ch;
        v4u iA, iB, rA[8], rB[8];
        { const unsigned short* ip0 = (const unsigned short*)(blk + 1024) + VP_ROW(0); iA = *(const v4u*)ip0; iB = *(const v4u*)(ip0 + 8); }
        EX_GATHER(rA, iA, VF8, vb);
        for (int g = 0; g < 16; ++g) {
            const int gn = g < 15 ? g + 1 : 15, jn = ((gn >> 1) + xg) & 7;
            const unsigned char* blkn = lds + (size_t)(64 * (gn & 1) + 8 * wave) * 512;
            const unsigned vbn = 128u * (unsigned)jn + 16u * (unsigned)ch;
            const int tw = t0 + wave * 8 + 64 * (g & 1);
#pragma unroll 1
            for (int tp = 0; tp < 4; ++tp) {
                const int t = tw + 2 * tp + sp;
                const bf16* xp = X1B + (size_t)t * D + 128 * j + 16 * ch + 4 * (gq & 1);
                const unsigned long xw0 = *(const unsigned long*)xp, xw1 = *(const unsigned long*)(xp + 8);
                const float osc = ((const float*)(blk + 3072))[2 * tp + sp];
#pragma unroll
                for (int hp = 0; hp < 2; ++hp) {
                    const int p = 2 * tp + hp; const bool last = p == 7;
                    const unsigned short* ipx = (const unsigned short*)((last ? blkn : blk) + 1024) + (last ? VP_ROW(0) : VP_ROW(p + 1));
                    const v4u iA2 = *(const v4u*)ipx, iB2 = *(const v4u*)(ipx + 8);
                    const v4u cw = *(const v4u*)(blk + VP_ROW(p));
                    EX_GATHER(rB, iB, VF8, vb); __builtin_amdgcn_sched_barrier(0);
                    VM_STEP8(rA, cw.x, cw.y); __builtin_amdgcn_sched_barrier(0);
                    { const unsigned vbx = last ? vbn : vb; EX_GATHER(rA, iA2, VF8, vbx); } __builtin_amdgcn_sched_barrier(0);
                    VM_STEP8(rB, cw.z, cw.w); __builtin_amdgcn_sched_barrier(0);
                    iB = iB2;
                }
                if (vld) { float* op = a.out + (size_t)t * D + 128 * j + 16 * ch + 4 * (gq & 1);
                    const unsigned a0 = (unsigned)xw0, a1 = (unsigned)(xw0 >> 32), b0 = (unsigned)xw1, b1 = (unsigned)(xw1 >> 32);
                    f32x4 o0, o1; o0.x = bflo(a0) + acc0.x * osc; o0.y = bfhi(a0) + acc0.y * osc; o0.z = bflo(a1) + acc0.z * osc; o0.w = bfhi(a1) + acc0.w * osc;
                    o1.x = bflo(b0) + acc1.x * osc; o1.y = bfhi(b0) + acc1.y * osc; o1.z = bflo(b1) + acc1.z * osc; o1.w = bfhi(b1) + acc1.w * osc;
                    *(f32x4*)op = o0; *(f32x4*)(op + 8) = o1; }
                acc0 = (f32x4){0.f, 0.f, 0.f, 0.f}; acc1 = (f32x4){0.f, 0.f, 0.f, 0.f};
            }
            blk = blkn; j = jn; vb = vbn;
        }
#undef VM_STEP8
#undef VP_ROW
    }
#undef EX_IDS
#undef EX_GATHER2
}

#ifndef PROBE_DUP
#define PROBE_DUP -1
#endif
#define REP(n) for (int rep_ = 0; rep_ < ((PROBE_DUP == (n)) ? 2 : 1); ++rep_, __syncthreads())
__global__ void __launch_bounds__(NWAVES * 64, 2) mega_fwd(Args args) {
    extern __shared__ __attribute__((aligned(16))) unsigned char lds[];
    const int tid = threadIdx.x, lane = tid & 63, wave = __builtin_amdgcn_readfirstlane(tid >> 6);
    const int G = gridDim.x, bx = blockIdx.x, vcu = (G % 8 == 0) ? (bx % 8) * (G / 8) + bx / 8 : bx;
    for (int u = tid; u < (LDS_BYTES - LDSCTL_OFF) / 4; u += NWAVES * 64) ((LAS unsigned*)((LAS unsigned char*)lds + LDSCTL_OFF))[u] = 0u;
    __syncthreads();
    volatile LAS unsigned* MISC = (volatile LAS unsigned*)((LAS unsigned char*)lds + MISC_OFF);
    XcdBarrier bar = xcd_barrier_post((unsigned*)(args.ws + WS_CTL) + CW_BAR, MISC + 8);
    unsigned char* ws = args.ws;
    const int gw = vcu * NWAVES + wave, NGW = G * NWAVES;

    REP(0) p0_prologue(args, lds, vcu, G, wave, lane, tid, 7);
#if PROBE_DUP >= 10 && PROBE_DUP <= 12
    __syncthreads(); p0_prologue(args, lds, vcu, G, wave, lane, tid, 1 << (PROBE_DUP - 10));
#endif
    xcd_barrier(bar);
    REP(1) { { int t2 = threadIdx.x; asm volatile("" : "+v"(t2)); p1_cumsum(args, lds, wave, t2 & 63, t2); }
    { pg8::Gemm g{(const pg8::bf16_t*)(ws + WS_XN), (const pg8::bf16_t*)(ws + WS_W1T), T, 2048, D}; pg8::StaticOrder S; S.init(T, 2048, G, bx);
      pg8::EpiQKV E{(pg8::bf16_t*)(ws + WS_ZP), args.in[4], args.in[5], (const float*)(ws + WS_R1)};
      pg8::gemm_phase<pg8::EpiQKV, pg8::StaticOrder, true, true>((LAS unsigned char*)lds, g, S, E); } }
    xcd_barrier(bar);
    REP(2) { const attn_body::AttnTensors AT{(const attn_body::bf16*)(ws + WS_Q), (const attn_body::bf16*)(ws + WS_K), (const attn_body::bf16*)(ws + WS_V), (attn_body::bf16*)(ws + WS_YC), (const float*)(ws + WS_FB)};
      attn_body::attn_phase_dyn<8>((char*)lds, AT, (unsigned*)(ws + WS_CTL) + 8192, args.in[4], args.in[5]); }
    REP(3) { int t2 = threadIdx.x; asm volatile("" : "+v"(t2)); p2_pool(args, vcu * NWAVES * 64 + t2, G * NWAVES * 64); }
    xcd_barrier(bar);
    REP(4) { pg8::Gemm g{(const pg8::bf16_t*)(ws + WS_YC), (const pg8::bf16_t*)(ws + WS_WOT), T, D, D}; pg8::StaticOrder S; S.init(T, D, G, bx);
      pg8::EpiX1 E{(const pg8::bf16_t*)(ws + WS_XN), args.out, (pg8::bf16_t*)(ws + WS_X1B), (float*)(ws + WS_RSQ)};
      pg8::gemm_phase<pg8::EpiX1, pg8::StaticOrder, true, true>((LAS unsigned char*)lds, g, S, E); }
    xcd_barrier(bar);
    REP(5) { pg8::Gemm g{(const pg8::bf16_t*)(ws + WS_X1B), (const pg8::bf16_t*)(ws + WS_WST), T, 2048, D}; pg8::StaticOrder S; S.init(T, 2048, G, bx);
      pg8::EpiSc E{(pg8::bf16_t*)(ws + WS_SC)};
      pg8::gemm_phase<pg8::EpiSc, pg8::StaticOrder, true, true>((LAS unsigned char*)lds, g, S, E); }
    xcd_barrier(bar);
    REP(6) { int t2 = threadIdx.x; asm volatile("" : "+v"(t2)); p5_route(args, lds, gw, NGW, wave, t2 & 63); }
    xcd_barrier(bar);
    REP(7) { int t2 = threadIdx.x; asm volatile("" : "+v"(t2)); p6_experts(args, lds, bx, vcu, wave, t2 & 63, t2); }
}

extern "C" void kernel_launch(void* const* d_in, const int* in_sizes, int n_in, void* d_out, int out_size, void* d_ws, size_t ws_size, hipStream_t stream) {
    static int grid = 0;
    if (grid == 0) {
        if (n_in != 14 || in_sizes[0] != T * D || out_size != T * D || ws_size < WS_END) { fprintf(stderr, "kernel_launch: unexpected shapes (n_in %d, in0 %d, out %d, ws %zu)\n", n_in, n_in > 0 ? in_sizes[0] : -1, out_size, ws_size); grid = -1; return; }
        int dev = 0, cus = 0, per_cu = 0;
        if (hipGetDevice(&dev) != hipSuccess || hipDeviceGetAttribute(&cus, hipDeviceAttributeMultiprocessorCount, dev) != hipSuccess) { grid = -1; return; }
        if (hipFuncSetAttribute((const void*)mega_fwd, hipFuncAttributeMaxDynamicSharedMemorySize, LDS_BYTES) != hipSuccess) { fprintf(stderr, "kernel_launch: hipFuncSetAttribute failed\n"); grid = -1; return; }
        if (hipOccupancyMaxActiveBlocksPerMultiprocessor(&per_cu, (const void*)mega_fwd, NWAVES * 64, LDS_BYTES) != hipSuccess || per_cu < 1) fprintf(stderr, "kernel_launch: occupancy query reports %d per CU\n", per_cu);
        (void)hipGetLastError();
        grid = cus;
        if (grid != 256) { fprintf(stderr, "kernel_launch: unsupported CU count %d\n", grid); grid = -1; return; }
    }
    if (grid < 0) return;
    if (hipMemsetAsync((char*)d_ws + WS_CTL, 0, CTL_ZERO_BYTES, stream) != hipSuccess) return;
    Args a{};
    for (int i = 0; i < 14; ++i) a.in[i] = (const float*)d_in[i];
    a.out = (float*)d_out; a.ws = (unsigned char*)d_ws;
    hipLaunchKernelGGL(mega_fwd, dim3(grid), dim3(NWAVES * 64), LDS_BYTES, stream, a);
}
```
